# Optimizing an MI355X kernel written in HIP

```python
import jax, jax.numpy as jnp
from jax import lax
import numpy as np

D_MODEL = 1024
BATCH = 8
SEQ = 2048
DEPTH = 2
DEC_BATCH = 128
DEC_SEQ = 1
PAST_LEN = 8192
PAGE_SIZE = 128

EPS = 1e-6
D_A = D_MODEL
CONV_A_W = 3
D_SSM = 2 * D_MODEL
SSM_HEADDIM = 64
H_SSM = D_SSM // SSM_HEADDIM
G_SSM = 8
N_SSM = 128
SSM_CONV_W = 4
SSM_CONV_DIM = D_SSM + 2 * G_SSM * N_SSM
SSD_CHUNK = 128
H_ATT = 16
KV_ATT = 4
HD_ATT = 64
ROT_DIM = HD_ATT // 4
ROPE_THETA = 500000.0
WINDOW = 128
MEM_LEN = 256
X_H = 4
X_HD = D_MODEL // X_H
D_FF = 2816
FFN_CONV_W = 3
N_BRANCH = 3
IN_SIZES = (D_A, D_A, D_A, D_SSM, SSM_CONV_DIM, H_SSM, H_ATT * HD_ATT, KV_ATT * HD_ATT, KV_ATT * HD_ATT, N_BRANCH * D_MODEL)
IN_DIM = sum(IN_SIZES)

kernel_name = 'hybrid_gated_parallel_decoder_step'


def split_cols(z, sizes):
    idx = np.cumsum(np.array(sizes))[:-1].tolist()
    return jnp.split(z, idx, axis=-1)


def rmsnorm(x, g):
    xf = x.astype(jnp.float32)
    y = xf * lax.rsqrt(jnp.mean(xf * xf, axis=-1, keepdims=True) + EPS)
    return (y * g.astype(jnp.float32)).astype(x.dtype)


def causal_dwconv(x, buf, w, b=None):
    L = x.shape[1]
    xx = jnp.concatenate([buf.astype(x.dtype), x], axis=1)
    y = xx[:, 0:L] * w[0]
    for k in range(1, w.shape[0]):
        y = y + xx[:, k:k + L] * w[k]
    if b is not None:
        y = y + b
    return y, xx[:, L:]


def partial_rope(x, pos):
    half = ROT_DIM // 2
    inv = ROPE_THETA ** (-jnp.arange(half, dtype=jnp.float32) / half)
    ang = pos.astype(jnp.float32)[:, None] * inv[None, :]
    cos = jnp.cos(ang)[None, :, None, :]
    sin = jnp.sin(ang)[None, :, None, :]
    xr = x[..., :ROT_DIM].astype(jnp.float32)
    x1, x2 = xr[..., :half], xr[..., half:]
    rot = jnp.concatenate([x1 * cos - x2 * sin, x2 * cos + x1 * sin], axis=-1)
    return jnp.concatenate([rot.astype(x.dtype), x[..., ROT_DIM:]], axis=-1)


def sink_attention(q, k, v, q_pos, k_pos, sinks):
    s = jnp.einsum('bnqgrd,bnkgd->bngrqk', q, k).astype(jnp.float32) * (HD_ATT ** -0.5)
    diff = q_pos[:, :, None] - k_pos[:, None, :]
    mask = (diff >= 0) & (diff < WINDOW) & (k_pos[:, None, :] >= 0)
    s = jnp.where(mask[None, :, None, None], s, -jnp.inf)
    sink = sinks.astype(jnp.float32).reshape(KV_ATT, H_ATT // KV_ATT)[None, None, :, :, None, None]
    m = jnp.maximum(jnp.max(s, axis=-1, keepdims=True), sink)
    e = jnp.exp(s - m)
    prob = e / (jnp.sum(e, axis=-1, keepdims=True) + jnp.exp(sink - m))
    return jnp.einsum('bngrqk,bnkgd->bnqgrd', prob.astype(v.dtype), v)


def ssd_scan(x, dt, A, B, C, h0):
    b, L, H, P = x.shape
    G, N = B.shape[2], B.shape[3]
    R = H // G
    Q = min(SSD_CHUNK, L)
    nc = -(-L // Q)
    pad = nc * Q - L
    f32 = jnp.float32
    x = jnp.pad(x.astype(f32), ((0, 0), (0, pad), (0, 0), (0, 0))).reshape(b, nc, Q, G, R, P)
    dt = jnp.pad(dt.astype(f32), ((0, 0), (0, pad), (0, 0))).reshape(b, nc, Q, G, R)
    B = jnp.pad(B.astype(f32), ((0, 0), (0, pad), (0, 0), (0, 0))).reshape(b, nc, Q, G, N)
    C = jnp.pad(C.astype(f32), ((0, 0), (0, pad), (0, 0), (0, 0))).reshape(b, nc, Q, G, N)
    cs = jnp.cumsum(dt * A.reshape(G, R), axis=2)
    xdt = x * dt[..., None]
    seg = cs[:, :, :, None] - cs[:, :, None, :]
    causal = jnp.tril(jnp.ones((Q, Q), dtype=bool))[:, :, None, None]
    Lmat = jnp.exp(jnp.where(causal, seg, -jnp.inf))
    CB = jnp.einsum('bclgn,bcsgn->bclsg', C, B)
    y_diag = jnp.einsum('bclsg,bclsgr,bcsgrp->bclgrp', CB, Lmat, xdt)
    decay_s = jnp.exp(cs[:, :, -1:] - cs)
    states = jnp.einsum('bcsgn,bcsgr,bcsgrp->bcgrpn', B, decay_s, xdt)
    chunk_decay = jnp.exp(cs[:, :, -1])

    def step(hc, inp):
        st, dec = inp
        return hc * dec[..., None, None] + st, hc

    h_last, h_prev = lax.scan(step, h0.astype(f32).reshape(b, G, R, P, N),
                              (jnp.moveaxis(states, 1, 0), jnp.moveaxis(chunk_decay, 1, 0)))
    h_prev = jnp.moveaxis(h_prev, 0, 1)
    y_off = jnp.einsum('bclgn,bcgrpn,bclgr->bclgrp', C, h_prev, jnp.exp(cs))
    y = (y_diag + y_off).reshape(b, nc * Q, H, P)[:, :L]
    return y, h_last.reshape(b, H, P, N)


def gated_parallel_mixer(h, pos, buf_a, buf_ssm, ssm0, swa_k, swa_v, p):
    b, L, _ = h.shape
    (v_a, gb_a, gc_a, z_s, xbc, dt_raw, q, k, v, gates) = split_cols(h @ p['w_in'], IN_SIZES)
    u_a, new_buf_a = causal_dwconv(gc_a * v_a, buf_a, p['conv_a_w'])
    y_a = (gb_a * u_a) @ p['w_a_out']
    xbc, new_buf_ssm = causal_dwconv(xbc, buf_ssm, p['ssm_conv_w'], p['ssm_conv_b'])
    xbc = jax.nn.silu(xbc)
    xs, Bs, Cs = split_cols(xbc, (D_SSM, G_SSM * N_SSM, G_SSM * N_SSM))
    dt = jax.nn.softplus((dt_raw + p['ssm_dt_bias']).astype(jnp.float32))
    A = -jnp.exp(p['ssm_a_log'].astype(jnp.float32))
    xh = xs.reshape(b, L, H_SSM, SSM_HEADDIM)
    y_s, new_ssm = ssd_scan(xh, dt, A, Bs.reshape(b, L, G_SSM, N_SSM), Cs.reshape(b, L, G_SSM, N_SSM), ssm0)
    y_s = (y_s + xh.astype(jnp.float32) * p['ssm_d'].astype(jnp.float32)[:, None]).astype(h.dtype)
    y_s = rmsnorm(y_s.reshape(b, L, D_SSM) * jax.nn.silu(z_s), p['ssm_norm'])
    y_b = y_s @ p['w_ssm_out']
    q = partial_rope(q.reshape(b, L, H_ATT, HD_ATT), pos).reshape(b, L, KV_ATT, H_ATT // KV_ATT, HD_ATT)
    k = partial_rope(k.reshape(b, L, KV_ATT, HD_ATT), pos)
    v = v.reshape(b, L, KV_ATT, HD_ATT)
    if swa_k is None:
        nb = L // WINDOW
        qb = q.reshape(b, nb, WINDOW, KV_ATT, H_ATT // KV_ATT, HD_ATT)
        zpad = jnp.zeros((b, WINDOW, KV_ATT, HD_ATT), k.dtype)
        kp = jnp.concatenate([zpad, k], axis=1).reshape(b, nb + 1, WINDOW, KV_ATT, HD_ATT)
        vp = jnp.concatenate([zpad, v], axis=1).reshape(b, nb + 1, WINDOW, KV_ATT, HD_ATT)
        kb = jnp.concatenate([kp[:, :-1], kp[:, 1:]], axis=2)
        vb = jnp.concatenate([vp[:, :-1], vp[:, 1:]], axis=2)
        q_pos = pos.reshape(nb, WINDOW)
        k_pos = (jnp.arange(nb)[:, None] - 1) * WINDOW + jnp.arange(2 * WINDOW)[None, :]
        o = sink_attention(qb, kb, vb, q_pos, k_pos, p['attn_sinks'])
        new_k, new_v = k[:, L - WINDOW:], v[:, L - WINDOW:]
    else:
        n_buf = swa_k.shape[1]
        kk = jnp.concatenate([swa_k.astype(k.dtype), k], axis=1)
        vv = jnp.concatenate([swa_v.astype(v.dtype), v], axis=1)
        k_pos = pos[0] - n_buf + jnp.arange(n_buf + L)
        o = sink_attention(q[:, None], kk[:, None], vv[:, None], pos[None], k_pos[None], p['attn_sinks'])
        new_k, new_v = kk[:, L:], vv[:, L:]
    y_c = o.reshape(b, L, H_ATT * HD_ATT) @ p['w_attn_out']
    g_a, g_b, g_c = split_cols(jax.nn.sigmoid(gates), (D_MODEL, D_MODEL, D_MODEL))
    out = (g_a * y_a + g_b * y_b + g_c * y_c) @ p['w_out']
    return out, (new_buf_a, new_buf_ssm, new_ssm, new_k, new_v)


def memory_kv(mem, p):
    b, M, _ = mem.shape
    m = rmsnorm(mem, p['norm_mem'])
    return (m @ p['w_xk']).reshape(b, M, X_H, X_HD), (m @ p['w_xv']).reshape(b, M, X_H, X_HD)


def cross_attention(h, mem_k, mem_v, p):
    b, L, _ = h.shape
    q = (h @ p['w_xq']).reshape(b, L, X_H, X_HD)
    s = jnp.einsum('bqhd,bkhd->bhqk', q, mem_k.astype(h.dtype)).astype(jnp.float32) * (X_HD ** -0.5)
    a = jax.nn.softmax(s, axis=-1).astype(h.dtype)
    o = jnp.einsum('bhqk,bkhd->bqhd', a, mem_v.astype(h.dtype)).reshape(b, L, X_H * X_HD)
    return o @ p['w_xo']


def conv_ffn(h, buf, p):
    a, g = split_cols(h @ p['w_ffn_in'], (D_FF, D_FF))
    a, new_buf = causal_dwconv(a, buf, p['ffn_conv_w'], p['ffn_conv_b'])
    return (jax.nn.silu(a) * g) @ p['w_ffn_out'], new_buf


def decoder_layer(x, pos, st, mem_k, mem_v, p):
    buf_a, buf_ssm, ssm0, swa_k, swa_v, buf_ffn = st
    m, mix_state = gated_parallel_mixer(rmsnorm(x, p['norm_mix_pre']), pos, buf_a, buf_ssm, ssm0, swa_k, swa_v, p)
    x = x + rmsnorm(m, p['norm_mix_post'])
    x = x + rmsnorm(cross_attention(rmsnorm(x, p['norm_x_pre']), mem_k, mem_v, p), p['norm_x_post'])
    f, new_buf_ffn = conv_ffn(rmsnorm(x, p['norm_ffn_pre']), buf_ffn, p)
    x = x + rmsnorm(f, p['norm_ffn_post'])
    return x, mix_state + (new_buf_ffn,)


def setup_inputs(seed: int = 0) -> dict:
    key = jax.random.key(seed)
    ks = list(jax.random.split(key, 48))

    def nrm(i, shape, scale):
        return scale * jax.random.normal(ks[i], shape, jnp.float32)

    def gain(i, shape):
        return 1.0 + nrm(i, shape, 0.05)

    n_rows = min(WINDOW, PAST_LEN)
    dt0 = jnp.exp(jax.random.uniform(ks[40], (DEPTH, H_SSM), jnp.float32, np.log(1e-3), np.log(1e-1)))
    return {
        'x_prompt': nrm(0, (BATCH, SEQ, D_MODEL), 1.0),
        'x_sample': nrm(1, (DEC_BATCH, DEC_SEQ, D_MODEL), 1.0),
        'mem_prompt': nrm(2, (BATCH, MEM_LEN, D_MODEL), 1.0),
        'state_conv_a': nrm(3, (DEPTH, DEC_BATCH, CONV_A_W - 1, D_A), 1.0),
        'state_ssm_conv': nrm(4, (DEPTH, DEC_BATCH, SSM_CONV_W - 1, SSM_CONV_DIM), 1.0),
        'state_ssm': nrm(5, (DEPTH, DEC_BATCH, H_SSM, SSM_HEADDIM, N_SSM), 0.1),
        'cache_swa_k': nrm(6, (DEPTH, DEC_BATCH, n_rows, KV_ATT, HD_ATT), 1.0),
        'cache_swa_v': nrm(7, (DEPTH, DEC_BATCH, n_rows, KV_ATT, HD_ATT), 1.0),
        'cache_mem_k': nrm(8, (DEPTH, DEC_BATCH, MEM_LEN, X_H, X_HD), 1.0),
        'cache_mem_v': nrm(9, (DEPTH, DEC_BATCH, MEM_LEN, X_H, X_HD), 1.0),
        'state_ffn_conv': nrm(10, (DEPTH, DEC_BATCH, FFN_CONV_W - 1, D_FF), 1.0),
        'norm_mix_pre': gain(11, (DEPTH, D_MODEL)),
        'norm_mix_post': gain(12, (DEPTH, D_MODEL)),
        'w_in': nrm(13, (DEPTH, D_MODEL, IN_DIM), D_MODEL ** -0.5),
        'conv_a_w': nrm(14, (DEPTH, CONV_A_W, D_A), CONV_A_W ** -0.5),
        'w_a_out': nrm(15, (DEPTH, D_A, D_MODEL), D_A ** -0.5),
        'ssm_conv_w': nrm(16, (DEPTH, SSM_CONV_W, SSM_CONV_DIM), SSM_CONV_W ** -0.5),
        'ssm_conv_b': nrm(17, (DEPTH, SSM_CONV_DIM), 0.02),
        'ssm_dt_bias': dt0 + jnp.log(-jnp.expm1(-dt0)),
        'ssm_a_log': jnp.log(jax.random.uniform(ks[18], (DEPTH, H_SSM), jnp.float32, 1.0, 16.0)),
        'ssm_d': 1.0 + nrm(19, (DEPTH, H_SSM), 0.1),
        'ssm_norm': gain(20, (DEPTH, D_SSM)),
        'w_ssm_out': nrm(21, (DEPTH, D_SSM, D_MODEL), D_SSM ** -0.5),
        'attn_sinks': nrm(22, (DEPTH, H_ATT), 0.5),
        'w_attn_out': nrm(23, (DEPTH, H_ATT * HD_ATT, D_MODEL), (H_ATT * HD_ATT) ** -0.5),
        'w_out': nrm(24, (DEPTH, D_MODEL, D_MODEL), D_MODEL ** -0.5),
        'norm_x_pre': gain(25, (DEPTH, D_MODEL)),
        'norm_x_post': gain(26, (DEPTH, D_MODEL)),
        'norm_mem': gain(27, (DEPTH, D_MODEL)),
        'w_xq': nrm(28, (DEPTH, D_MODEL, X_H * X_HD), D_MODEL ** -0.5),
        'w_xk': nrm(29, (DEPTH, D_MODEL, X_H * X_HD), D_MODEL ** -0.5),
        'w_xv': nrm(30, (DEPTH, D_MODEL, X_H * X_HD), D_MODEL ** -0.5),
        'w_xo': nrm(31, (DEPTH, X_H * X_HD, D_MODEL), (X_H * X_HD) ** -0.5),
        'norm_ffn_pre': gain(32, (DEPTH, D_MODEL)),
        'norm_ffn_post': gain(33, (DEPTH, D_MODEL)),
        'w_ffn_in': nrm(34, (DEPTH, D_MODEL, 2 * D_FF), D_MODEL ** -0.5),
        'ffn_conv_w': nrm(35, (DEPTH, FFN_CONV_W, D_FF), FFN_CONV_W ** -0.5),
        'ffn_conv_b': nrm(36, (DEPTH, D_FF), 0.02),
        'w_ffn_out': nrm(37, (DEPTH, D_FF, D_MODEL), D_FF ** -0.5),
    }


def reference(x_prompt, x_sample, mem_prompt, state_conv_a, state_ssm_conv, state_ssm, cache_swa_k, cache_swa_v,
              cache_mem_k, cache_mem_v, state_ffn_conv, norm_mix_pre, norm_mix_post, w_in, conv_a_w, w_a_out,
              ssm_conv_w, ssm_conv_b, ssm_dt_bias, ssm_a_log, ssm_d, ssm_norm, w_ssm_out, attn_sinks, w_attn_out,
              w_out, norm_x_pre, norm_x_post, norm_mem, w_xq, w_xk, w_xv, w_xo, norm_ffn_pre, norm_ffn_post,
              w_ffn_in, ffn_conv_w, ffn_conv_b, w_ffn_out):
    bp, Lp, _ = x_prompt.shape
    Ls = x_sample.shape[1]
    pos_p = jnp.arange(Lp, dtype=jnp.int32)
    pos_s = PAST_LEN + jnp.arange(Ls, dtype=jnp.int32)
    yp, ys = x_prompt, x_sample
    new_p, new_s = [], []
    for l in range(DEPTH):
        p = {'norm_mix_pre': norm_mix_pre[l], 'norm_mix_post': norm_mix_post[l], 'w_in': w_in[l],
             'conv_a_w': conv_a_w[l], 'w_a_out': w_a_out[l], 'ssm_conv_w': ssm_conv_w[l],
             'ssm_conv_b': ssm_conv_b[l], 'ssm_dt_bias': ssm_dt_bias[l], 'ssm_a_log': ssm_a_log[l],
             'ssm_d': ssm_d[l], 'ssm_norm': ssm_norm[l], 'w_ssm_out': w_ssm_out[l], 'attn_sinks': attn_sinks[l],
             'w_attn_out': w_attn_out[l], 'w_out': w_out[l], 'norm_x_pre': norm_x_pre[l],
             'norm_x_post': norm_x_post[l], 'norm_mem': norm_mem[l], 'w_xq': w_xq[l], 'w_xk': w_xk[l],
             'w_xv': w_xv[l], 'w_xo': w_xo[l], 'norm_ffn_pre': norm_ffn_pre[l], 'norm_ffn_post': norm_ffn_post[l],
             'w_ffn_in': w_ffn_in[l], 'ffn_conv_w': ffn_conv_w[l], 'ffn_conv_b': ffn_conv_b[l],
             'w_ffn_out': w_ffn_out[l]}
        zero_st = (jnp.zeros((bp, CONV_A_W - 1, D_A), yp.dtype),
                   jnp.zeros((bp, SSM_CONV_W - 1, SSM_CONV_DIM), yp.dtype),
                   jnp.zeros((bp, H_SSM, SSM_HEADDIM, N_SSM), jnp.float32),
                   None, None,
                   jnp.zeros((bp, FFN_CONV_W - 1, D_FF), yp.dtype))
        mk, mv = memory_kv(mem_prompt, p)
        yp, st_p = decoder_layer(yp, pos_p, zero_st, mk, mv, p)
        new_p.append(st_p + (mk, mv))
        st_in = (state_conv_a[l], state_ssm_conv[l], state_ssm[l], cache_swa_k[l], cache_swa_v[l], state_ffn_conv[l])
        ys, st_s = decoder_layer(ys, pos_s, st_in, cache_mem_k[l], cache_mem_v[l], p)
        new_s.append(st_s)
    p_conv_a = jnp.stack([s[0] for s in new_p])
    p_ssm_conv = jnp.stack([s[1] for s in new_p])
    p_ssm = jnp.stack([s[2] for s in new_p])
    p_swa_k = jnp.stack([s[3] for s in new_p])
    p_swa_v = jnp.stack([s[4] for s in new_p])
    p_ffn_conv = jnp.stack([s[5] for s in new_p])
    p_mem_k = jnp.stack([s[6] for s in new_p])
    p_mem_v = jnp.stack([s[7] for s in new_p])
    s_conv_a = jnp.stack([s[0] for s in new_s])
    s_ssm_conv = jnp.stack([s[1] for s in new_s])
    s_ssm = jnp.stack([s[2] for s in new_s])
    s_swa_k = jnp.stack([s[3] for s in new_s])
    s_swa_v = jnp.stack([s[4] for s in new_s])
    s_ffn_conv = jnp.stack([s[5] for s in new_s])
    return (yp, ys, p_conv_a, p_ssm_conv, p_ssm, p_swa_k, p_swa_v, p_ffn_conv, p_mem_k, p_mem_v,
            s_conv_a, s_ssm_conv, s_ssm, s_swa_k, s_swa_v, s_ffn_conv)
```

```cpp
#include <hip/hip_runtime.h>
#include <cstdio>
#include <cstdint>

typedef unsigned short bf16;
typedef float f32x4 __attribute__((ext_vector_type(4)));
typedef unsigned u32x4 __attribute__((ext_vector_type(4)));
typedef unsigned u32x2 __attribute__((ext_vector_type(2)));

constexpr int D = 1024, BATCH = 8, SEQ = 2048, DEPTH = 2, DB = 128;
constexpr int RPROMPT = BATCH * SEQ;
constexpr int R = RPROMPT + DB;
constexpr int RPAD = 16640;
constexpr int DSSM = 2048, H_SSM = 32, P_SSM = 64, G_SSM = 8, N_SSM = 128, CD = 4096;
constexpr int H_ATT = 16, KV_ATT = 4, HD = 64, WINDOW = 128;
constexpr int MEM = 256, XH = 4, XHD = 256;
constexpr int DFF = 2816;
constexpr int IN_DIM = 13856, IN_PAD = 14080;
constexpr int PAST_LEN = 8192;
constexpr float EPS = 1e-6f;
constexpr int C_VA = 0, C_GB = 1024, C_GC = 2048, C_ZS = 3072, C_XBC = 5120, C_DT = 9216, C_Q = 9248, C_K = 10272, C_V = 10528, C_G = 10784;
static_assert(C_G + 3 * D == IN_DIM, "in-proj partition");

enum { I_XP = 0, I_XS, I_MEM, I_SCA, I_SSC, I_SSM, I_SWK, I_SWV, I_CMK, I_CMV, I_SFC, I_NMPRE, I_NMPOST, I_WIN, I_CAW, I_WAO, I_SCW, I_SCB, I_DTB, I_ALOG, I_SSD,
       I_SSN, I_WSO, I_SINK, I_WATT, I_WOUT, I_NXPRE, I_NXPOST, I_NMEM, I_WXQ, I_WXK, I_WXV, I_WXO, I_NFPRE, I_NFPOST, I_WFI, I_FCW, I_FCB, I_WFO, N_IN };
static_assert(N_IN == 39, "39 inputs");

constexpr size_t O_YP = 0, O_YS = 16777216, O_PCA = 16908288, O_PSC = 16941056, O_PSSM = 17137664, O_PSWK = 21331968, O_PSWV = 21856256, O_PFC = 22380544,
                 O_PMK = 22470656, O_PMV = 26664960, O_SCA = 30859264, O_SSC = 31383552, O_SSSM = 34529280, O_SSWK = 101638144, O_SSWV = 110026752, O_SFC = 118415360,
                 O_END = 119857152;

constexpr size_t MiB = 1u << 20;
constexpr size_t WS_CTL = 0;
constexpr size_t WS_W = 2 * MiB, W_LAYER = 64 * MiB;
constexpr size_t W_IN = 0, W_A = 28 * MiB, W_SSM = 30 * MiB, W_ATT = 34 * MiB, W_OUT = 36 * MiB, W_XQ = 38 * MiB, W_XKV = 40 * MiB, W_XO = 44 * MiB, W_FFI = 46 * MiB, W_FFO = 58 * MiB;
constexpr size_t WS_Z = 130 * MiB;
constexpr size_t WS_AG = WS_Z;
constexpr size_t WS_HID = WS_Z + 180 * MiB;
constexpr size_t WS_XBC = 578 * MiB;
constexpr size_t WS_YG = 708 * MiB;
constexpr size_t WS_XN = 773 * MiB;
constexpr size_t WS_B1 = 806 * MiB;
constexpr size_t WS_B2 = 839 * MiB;
constexpr size_t WS_B3 = 872 * MiB;
constexpr size_t WS_B4 = 905 * MiB;
constexpr size_t WS_F0 = 938 * MiB;
constexpr size_t WS_F1 = 1003 * MiB;
constexpr size_t WS_KR = 1068 * MiB;
constexpr size_t WS_DT = 1077 * MiB;
constexpr size_t WS_MN = 1080 * MiB, WS_MK = 1084 * MiB, WS_MV = 1088 * MiB;
constexpr size_t WS_END = 1092 * MiB;
static_assert((size_t)RPAD * IN_PAD * 2 <= 448 * MiB && (size_t)RPAD * 2 * DFF * 2 <= 180 * MiB && WS_HID + (size_t)RPAD * DFF * 2 <= WS_XBC, "ws map");

struct Params { const float* in[N_IN]; float* out; unsigned char* ws; };

__device__ __forceinline__ float bf2f(unsigned v) { return __uint_as_float(v << 16); }
__device__ __forceinline__ unsigned f2bf(float f) { unsigned u = __float_as_uint(f); return (u + 0x7fffu + ((u >> 16) & 1u)) >> 16; }
__device__ __forceinline__ unsigned pk2(float lo, float hi) { return f2bf(lo) | (f2bf(hi) << 16); }
__device__ __forceinline__ void ld8(const bf16* p, float (&o)[8]) {
    const u32x4 w = *(const u32x4*)p;
    o[0] = bf2f(w.x & 0xffffu); o[1] = bf2f(w.x >> 16); o[2] = bf2f(w.y & 0xffffu); o[3] = bf2f(w.y >> 16);
    o[4] = bf2f(w.z & 0xffffu); o[5] = bf2f(w.z >> 16); o[6] = bf2f(w.w & 0xffffu); o[7] = bf2f(w.w >> 16);
}
__device__ __forceinline__ void st8(bf16* p, const float (&v)[8]) {
    u32x4 w; w.x = pk2(v[0], v[1]); w.y = pk2(v[2], v[3]); w.z = pk2(v[4], v[5]); w.w = pk2(v[6], v[7]); *(u32x4*)p = w;
}
__device__ __forceinline__ void ld8f(const float* p, float (&o)[8]) {
    const f32x4 a = *(const f32x4*)p, b = *(const f32x4*)(p + 4);
    o[0] = a.x; o[1] = a.y; o[2] = a.z; o[3] = a.w; o[4] = b.x; o[5] = b.y; o[6] = b.z; o[7] = b.w;
}
__device__ __forceinline__ void st8f(float* p, const float (&v)[8]) {
    *(f32x4*)p = (f32x4){v[0], v[1], v[2], v[3]}; *(f32x4*)(p + 4) = (f32x4){v[4], v[5], v[6], v[7]};
}
__device__ __forceinline__ float wave_sum(float v) {
#pragma unroll
    for (int o = 1; o < 64; o <<= 1) v += __shfl_xor(v, o);
    return v;
}
__device__ __forceinline__ float wave_max(float v) {
#pragma unroll
    for (int o = 1; o < 64; o <<= 1) v = fmaxf(v, __shfl_xor(v, o));
    return v;
}
__device__ __forceinline__ float sigmoidf_(float x) { return 1.f / (1.f + __expf(-x)); }
__device__ __forceinline__ float siluf_(float x) { return x / (1.f + __expf(-x)); }
__device__ __forceinline__ float softplusf_(float x) { return x > 20.f ? x : log1pf(expf(x)); }

__global__ void __launch_bounds__(256) k_wconv(const float* W, long K_, long N_, bf16* WT, long row_off_) {
    const int K = (int)K_, N = (int)N_, row_off = (int)row_off_;
    __shared__ float scr_all[4][64 * 33];
    const int lane = threadIdx.x & 63, wave = threadIdx.x >> 6;
    float* scr = scr_all[wave];
    const int nblk = N / 32, nitems = (K / 64) * nblk;
    for (int item = blockIdx.x * 4 + wave; item < nitems; item += gridDim.x * 4) {
        const int kb = item / nblk, nb = item % nblk, k0 = 64 * kb, n0 = 32 * nb;
#pragma unroll 8
        for (int i = 0; i < 32; ++i) { const int kk = 2 * i + (lane >> 5); scr[kk * 33 + (lane & 31)] = W[(size_t)(k0 + kk) * N + n0 + (lane & 31)]; }
        __builtin_amdgcn_s_waitcnt(0); __builtin_amdgcn_wave_barrier();
        const int c = lane & 7;
#pragma unroll
        for (int j = 0; j < 4; ++j) { const int n = (lane >> 3) + 8 * j; const float* s = scr + (8 * c) * 33 + n;
            u32x4 o; o.x = pk2(s[0 * 33], s[1 * 33]); o.y = pk2(s[2 * 33], s[3 * 33]); o.z = pk2(s[4 * 33], s[5 * 33]); o.w = pk2(s[6 * 33], s[7 * 33]);
            *(u32x4*)(WT + (size_t)(row_off + n0 + n) * K + k0 + 8 * c) = o; }
        __builtin_amdgcn_s_waitcnt(0); __builtin_amdgcn_wave_barrier();
    }
}

__global__ void __launch_bounds__(256) k_xinit(Params p) {
    const int lane = threadIdx.x & 63, gw = (blockIdx.x * blockDim.x + threadIdx.x) >> 6, nw = (gridDim.x * blockDim.x) >> 6;
    bf16* XN = (bf16*)(p.ws + WS_XN); const float* g = p.in[I_NMPRE];
    for (int r = gw; r < R; r += nw) {
        const float* src = r < RPROMPT ? p.in[I_XP] + (size_t)r * D : p.in[I_XS] + (size_t)(r - RPROMPT) * D;
        f32x4 v[4]; float ss = 0.f;
#pragma unroll
        for (int j = 0; j < 4; ++j) { v[j] = *(const f32x4*)(src + lane * 4 + j * 256); ss += v[j].x * v[j].x + v[j].y * v[j].y + v[j].z * v[j].z + v[j].w * v[j].w;
            *(f32x4*)(p.out + (size_t)r * D + lane * 4 + j * 256) = v[j]; }
        const float rstd = rsqrtf(wave_sum(ss) * (1.f / D) + EPS);
#pragma unroll
        for (int j = 0; j < 4; ++j) { const f32x4 gg = *(const f32x4*)(g + lane * 4 + j * 256);
            u32x2 w; w.x = pk2(v[j].x * rstd * gg.x, v[j].y * rstd * gg.y); w.y = pk2(v[j].z * rstd * gg.z, v[j].w * rstd * gg.w);
            *(u32x2*)(XN + (size_t)r * D + lane * 4 + j * 256) = w; }
    }
}
__global__ void __launch_bounds__(256) k_normrows(const float* src, long rows_, const float* g, bf16* dst) {
    const int rows = (int)rows_;
    const int lane = threadIdx.x & 63, gw = (blockIdx.x * blockDim.x + threadIdx.x) >> 6, nw = (gridDim.x * blockDim.x) >> 6;
    for (int r = gw; r < rows; r += nw) {
        f32x4 v[4]; float ss = 0.f;
#pragma unroll
        for (int j = 0; j < 4; ++j) { v[j] = *(const f32x4*)(src + (size_t)r * D + lane * 4 + j * 256); ss += v[j].x * v[j].x + v[j].y * v[j].y + v[j].z * v[j].z + v[j].w * v[j].w; }
        const float rstd = rsqrtf(wave_sum(ss) * (1.f / D) + EPS);
#pragma unroll
        for (int j = 0; j < 4; ++j) { const f32x4 gg = *(const f32x4*)(g + lane * 4 + j * 256);
            u32x2 w; w.x = pk2(v[j].x * rstd * gg.x, v[j].y * rstd * gg.y); w.y = pk2(v[j].z * rstd * gg.z, v[j].w * rstd * gg.w);
            *(u32x2*)(dst + (size_t)r * D + lane * 4 + j * 256) = w; }
    }
}

struct EpiStoreBf16 { bf16* O; long ldo; __device__ __forceinline__ void operator()(int row, int col, f32x4 v) const {
    u32x2 w; w.x = pk2(v.x, v.y); w.y = pk2(v.z, v.w); *(u32x2*)(O + (size_t)row * ldo + col) = w; } };
struct EpiStoreF32 { float* O; long ldo; __device__ __forceinline__ void operator()(int row, int col, f32x4 v) const { *(f32x4*)(O + (size_t)row * ldo + col) = v; } };
struct EpiMemKV { float* outk; float* outv; bf16* MK; bf16* MV; __device__ __forceinline__ void operator()(int row, int col, f32x4 v) const {
    u32x2 w; w.x = pk2(v.x, v.y); w.y = pk2(v.z, v.w);
    if (col < 1024) { *(f32x4*)(outk + (size_t)row * 1024 + col) = v; *(u32x2*)(MK + (size_t)row * 1024 + col) = w; }
    else { *(f32x4*)(outv + (size_t)row * 1024 + col - 1024) = v; *(u32x2*)(MV + (size_t)row * 1024 + col - 1024) = w; } } };
template <int WHICH> struct EpiGate { const bf16* Z; float* MIXF; bf16* MIX; __device__ __forceinline__ void operator()(int row, int col, f32x4 v) const {
    const u32x2 gz = *(const u32x2*)(Z + (size_t)row * IN_PAD + C_G + WHICH * D + col);
    f32x4 g; g.x = sigmoidf_(bf2f(gz.x & 0xffffu)); g.y = sigmoidf_(bf2f(gz.x >> 16)); g.z = sigmoidf_(bf2f(gz.y & 0xffffu)); g.w = sigmoidf_(bf2f(gz.y >> 16));
    f32x4 t = g * v; float* mp = MIXF + (size_t)row * D + col;
    if (WHICH > 0) t += *(const f32x4*)mp;
    if (WHICH < 2) *(f32x4*)mp = t;
    else { u32x2 w; w.x = pk2(t.x, t.y); w.y = pk2(t.z, t.w); *(u32x2*)(MIX + (size_t)row * D + col) = w; } } };

template <class Epi> __global__ void __launch_bounds__(256) k_gemm(const bf16* A, long lda_, const bf16* Bt, long K_, long M_, long N_, Epi epi) {
    const int lda = (int)lda_, K = (int)K_, M = (int)M_, N = (int)N_;
    __shared__ float As[32][68], Bs[32][68];
    const int tid = threadIdx.x, tx = tid & 15, ty = tid >> 4;
    const int ntn = N / 64, ntiles = (M / 64) * ntn;
    for (int tile = blockIdx.x; tile < ntiles; tile += gridDim.x) {
        const int m0 = (tile / ntn) * 64, n0 = (tile % ntn) * 64;
        float acc[4][4];
#pragma unroll
        for (int i = 0; i < 4; ++i)
#pragma unroll
            for (int j = 0; j < 4; ++j) acc[i][j] = 0.f;
        const int lr = tid >> 2, lk = (tid & 3) * 8;
        for (int k0 = 0; k0 < K; k0 += 32) {
            float a[8], b[8];
            ld8(A + (size_t)(m0 + lr) * lda + k0 + lk, a); ld8(Bt + (size_t)(n0 + lr) * K + k0 + lk, b);
            __syncthreads();
#pragma unroll
            for (int i = 0; i < 8; ++i) { As[lk + i][lr] = a[i]; Bs[lk + i][lr] = b[i]; }
            __syncthreads();
#pragma unroll
            for (int k = 0; k < 32; ++k) {
                const f32x4 av = *(const f32x4*)&As[k][ty * 4], bv = *(const f32x4*)&Bs[k][tx * 4];
#pragma unroll
                for (int i = 0; i < 4; ++i) { acc[i][0] += av[i] * bv.x; acc[i][1] += av[i] * bv.y; acc[i][2] += av[i] * bv.z; acc[i][3] += av[i] * bv.w; }
            }
        }
#pragma unroll
        for (int i = 0; i < 4; ++i) epi(m0 + ty * 4 + i, n0 + tx * 4, (f32x4){acc[i][0], acc[i][1], acc[i][2], acc[i][3]});
        __syncthreads();
    }
}

__global__ void __launch_bounds__(256) k_mixa(Params p, long l_) {
    const int l = (int)l_;
    const bf16* Z = (const bf16*)(p.ws + WS_Z); bf16* UA = (bf16*)(p.ws + WS_B1);
    const float* cw = p.in[I_CAW] + (size_t)l * 3 * D;
    const int nitems = R * 128;
    for (int it = blockIdx.x * blockDim.x + threadIdx.x; it < nitems; it += gridDim.x * blockDim.x) {
        const int r = it >> 7, c0 = (it & 127) * 8;
        float w0[8], w1[8], w2[8], a[8], b[8], gb[8], c[3][8], u[8];
        const bf16* zr = Z + (size_t)r * IN_PAD;
        ld8(zr + C_GC + c0, a); ld8(zr + C_VA + c0, b); ld8(zr + C_GB + c0, gb);
#pragma unroll
        for (int i = 0; i < 8; ++i) w2[i] = a[i] * b[i];
        if (r < RPROMPT) {
            const int t = r & (SEQ - 1);
            if (t >= 1) { ld8(zr - IN_PAD + C_GC + c0, a); ld8(zr - IN_PAD + C_VA + c0, b);
#pragma unroll
                for (int i = 0; i < 8; ++i) w1[i] = a[i] * b[i]; }
            else {
#pragma unroll
                for (int i = 0; i < 8; ++i) w1[i] = 0.f; }
            if (t >= 2) { ld8(zr - 2 * IN_PAD + C_GC + c0, a); ld8(zr - 2 * IN_PAD + C_VA + c0, b);
#pragma unroll
                for (int i = 0; i < 8; ++i) w0[i] = a[i] * b[i]; }
            else {
#pragma unroll
                for (int i = 0; i < 8; ++i) w0[i] = 0.f; }
            if (t >= SEQ - 2) st8f(p.out + O_PCA + (((size_t)l * BATCH + (r >> 11)) * 2 + (t - (SEQ - 2))) * D + c0, w2);
        } else {
            const int bb = r - RPROMPT; const float* buf = p.in[I_SCA] + ((size_t)l * DB + bb) * 2 * D;
            ld8f(buf + c0, w0); ld8f(buf + D + c0, w1);
            float* so = p.out + O_SCA + ((size_t)l * DB + bb) * 2 * D;
            st8f(so + c0, w1); st8f(so + D + c0, w2);
        }
        ld8f(cw + c0, c[0]); ld8f(cw + D + c0, c[1]); ld8f(cw + 2 * D + c0, c[2]);
#pragma unroll
        for (int i = 0; i < 8; ++i) u[i] = gb[i] * (c[0][i] * w0[i] + c[1][i] * w1[i] + c[2][i] * w2[i]);
        st8(UA + (size_t)r * D + c0, u);
    }
}
__global__ void __launch_bounds__(256) k_ssmconv(Params p, long l_) {
    const int l = (int)l_;
    const bf16* Z = (const bf16*)(p.ws + WS_Z); bf16* XBC = (bf16*)(p.ws + WS_XBC);
    const float* cw = p.in[I_SCW] + (size_t)l * 4 * CD; const float* cb = p.in[I_SCB] + (size_t)l * CD;
    const int nitems = R * (CD / 8);
    for (int it = blockIdx.x * blockDim.x + threadIdx.x; it < nitems; it += gridDim.x * blockDim.x) {
        const int r = it / (CD / 8), c0 = (it % (CD / 8)) * 8;
        float x[4][8], c[8], acc[8];
        const bf16* zr = Z + (size_t)r * IN_PAD + C_XBC + c0;
        ld8(zr, x[3]);
        if (r < RPROMPT) {
            const int t = r & (SEQ - 1);
#pragma unroll
            for (int k = 0; k < 3; ++k) {
                if (t - 3 + k >= 0) ld8(zr - (size_t)(3 - k) * IN_PAD, x[k]);
                else {
#pragma unroll
                    for (int i = 0; i < 8; ++i) x[k][i] = 0.f; }
            }
            if (t >= SEQ - 3) st8f(p.out + O_PSC + (((size_t)l * BATCH + (r >> 11)) * 3 + (t - (SEQ - 3))) * CD + c0, x[3]);
        } else {
            const int bb = r - RPROMPT; const float* buf = p.in[I_SSC] + ((size_t)l * DB + bb) * 3 * CD;
            ld8f(buf + c0, x[0]); ld8f(buf + CD + c0, x[1]); ld8f(buf + 2 * CD + c0, x[2]);
            float* so = p.out + O_SSC + ((size_t)l * DB + bb) * 3 * CD;
            st8f(so + c0, x[1]); st8f(so + CD + c0, x[2]); st8f(so + 2 * CD + c0, x[3]);
        }
        ld8f(cb + c0, acc);
#pragma unroll
        for (int k = 0; k < 4; ++k) { ld8f(cw + (size_t)k * CD + c0, c);
#pragma unroll
            for (int i = 0; i < 8; ++i) acc[i] += c[i] * x[k][i]; }
#pragma unroll
        for (int i = 0; i < 8; ++i) acc[i] = siluf_(acc[i]);
        st8(XBC + (size_t)r * CD + c0, acc);
    }
}
__global__ void __launch_bounds__(256) k_dt(Params p, long l_) {
    const int l = (int)l_;
    const bf16* Z = (const bf16*)(p.ws + WS_Z); float* DT = (float*)(p.ws + WS_DT);
    const float* dtb = p.in[I_DTB] + l * H_SSM;
    for (int it = blockIdx.x * blockDim.x + threadIdx.x; it < R * H_SSM; it += gridDim.x * blockDim.x) {
        const int r = it >> 5, h = it & 31;
        DT[it] = softplusf_(bf2f(Z[(size_t)r * IN_PAD + C_DT + h]) + dtb[h]);
    }
}
__constant__ float c_inv_freq[8] = {1.0f, 0.19392274474868576f, 0.03760603093086393f, 0.007292664737217109f, 0.001414213562373095f, 0.0002742481756762073f, 5.318295896944988e-05f, 1.031338537721246e-05f};
__global__ void __launch_bounds__(256) k_rope(Params p, long l_) {
    const int l = (int)l_;
    const bf16* Z = (const bf16*)(p.ws + WS_Z); bf16* QR = (bf16*)(p.ws + WS_B2); bf16* KR = (bf16*)(p.ws + WS_KR);
    for (int it = blockIdx.x * blockDim.x + threadIdx.x; it < R * 20; it += gridDim.x * blockDim.x) {
        const int r = it / 20, hs = it % 20;
        const bool isq = hs < 16; const int hh = isq ? hs : hs - 16;
        const bf16* src = Z + (size_t)r * IN_PAD + (isq ? C_Q : C_K) + hh * HD;
        bf16* dst = isq ? QR + (size_t)r * D + hh * HD : KR + (size_t)r * 256 + hh * HD;
        const int t = r < RPROMPT ? (r & (SEQ - 1)) : 0;
        const float pos = r < RPROMPT ? (float)t : (float)PAST_LEN;
        float v[8][8];
#pragma unroll
        for (int j = 0; j < 8; ++j) ld8(src + j * 8, v[j]);
        float x1[8], x2[8];
#pragma unroll
        for (int i = 0; i < 8; ++i) { float sn, cs; sincosf(pos * c_inv_freq[i], &sn, &cs); x1[i] = v[0][i] * cs - v[1][i] * sn; x2[i] = v[1][i] * cs + v[0][i] * sn; }
#pragma unroll
        for (int i = 0; i < 8; ++i) { v[0][i] = x1[i]; v[1][i] = x2[i]; }
#pragma unroll
        for (int j = 0; j < 8; ++j) st8(dst + j * 8, v[j]);
        if (!isq) {
            float vv[8][8];
#pragma unroll
            for (int j = 0; j < 8; ++j) ld8(Z + (size_t)r * IN_PAD + C_V + hh * HD + j * 8, vv[j]);
            float* ok = nullptr; float* ov = nullptr;
            if (r < RPROMPT) { if (t >= SEQ - WINDOW) { const size_t o = ((((size_t)l * BATCH + (r >> 11)) * WINDOW + (t - (SEQ - WINDOW))) * KV_ATT + hh) * HD; ok = p.out + O_PSWK + o; ov = p.out + O_PSWV + o; } }
            else { const size_t o = ((((size_t)l * DB + (r - RPROMPT)) * WINDOW + (WINDOW - 1)) * KV_ATT + hh) * HD; ok = p.out + O_SSWK + o; ov = p.out + O_SSWV + o; }
            if (ok) {
#pragma unroll
                for (int j = 0; j < 8; ++j) { st8f(ok + j * 8, v[j]); st8f(ov + j * 8, vv[j]); }
            }
        }
    }
}
__global__ void __launch_bounds__(256) k_swashift(Params p, long l_) {
    const int l = (int)l_;
    const size_t per_b = (size_t)WINDOW * KV_ATT * HD, n4 = (size_t)DB * (WINDOW - 1) * KV_ATT * HD / 4, row4 = (size_t)(WINDOW - 1) * KV_ATT * HD / 4;
    const float* ck = p.in[I_SWK] + (size_t)l * DB * per_b; const float* cv = p.in[I_SWV] + (size_t)l * DB * per_b;
    float* ok = p.out + O_SSWK + (size_t)l * DB * per_b; float* ov = p.out + O_SSWV + (size_t)l * DB * per_b;
    for (size_t i = blockIdx.x * (size_t)blockDim.x + threadIdx.x; i < n4; i += (size_t)gridDim.x * blockDim.x) {
        const size_t b = i / row4, j = i % row4;
        *(f32x4*)(ok + b * per_b + j * 4) = *(const f32x4*)(ck + b * per_b + KV_ATT * HD + j * 4);
        *(f32x4*)(ov + b * per_b + j * 4) = *(const f32x4*)(cv + b * per_b + KV_ATT * HD + j * 4);
    }
}

__global__ void __launch_bounds__(512) k_ssd(Params p, long l_) {
    const int l = (int)l_;
    const bf16* Z = (const bf16*)(p.ws + WS_Z); const bf16* XBC = (const bf16*)(p.ws + WS_XBC); const float* DT = (const float*)(p.ws + WS_DT); bf16* YG = (bf16*)(p.ws + WS_YG);
    const int tid = threadIdx.x, pp = tid >> 3, nq = tid & 7;
    const int nunits = BATCH * H_SSM + DB * H_SSM;
    for (int unit = blockIdx.x; unit < nunits; unit += gridDim.x) {
        const bool smp = unit >= BATCH * H_SSM;
        const int bb = smp ? (unit - BATCH * H_SSM) / H_SSM : unit / H_SSM, hh = unit % H_SSM, g = hh >> 2;
        const float A = -expf(p.in[I_ALOG][l * H_SSM + hh]), Dh = p.in[I_SSD][l * H_SSM + hh];
        float h[16];
        if (smp) { const float* s0 = p.in[I_SSM] + ((((size_t)l * DB + bb) * H_SSM + hh) * P_SSM + pp) * N_SSM + nq * 16;
#pragma unroll
            for (int i = 0; i < 4; ++i) { const f32x4 v = *(const f32x4*)(s0 + 4 * i); h[4 * i] = v.x; h[4 * i + 1] = v.y; h[4 * i + 2] = v.z; h[4 * i + 3] = v.w; } }
        else {
#pragma unroll
            for (int i = 0; i < 16; ++i) h[i] = 0.f; }
        const int r0 = smp ? RPROMPT + bb : bb * SEQ, L = smp ? 1 : SEQ;
        for (int t = 0; t < L; ++t) {
            const int r = r0 + t;
            const bf16* xr = XBC + (size_t)r * CD;
            const float x = bf2f(xr[hh * P_SSM + pp]), dt = DT[r * H_SSM + hh];
            float Bv[16], Cv[16];
            { float t0[8], t1[8]; ld8(xr + DSSM + g * N_SSM + nq * 16, t0); ld8(xr + DSSM + g * N_SSM + nq * 16 + 8, t1);
#pragma unroll
              for (int i = 0; i < 8; ++i) { Bv[i] = t0[i]; Bv[8 + i] = t1[i]; }
              ld8(xr + DSSM + G_SSM * N_SSM + g * N_SSM + nq * 16, t0); ld8(xr + DSSM + G_SSM * N_SSM + g * N_SSM + nq * 16 + 8, t1);
#pragma unroll
              for (int i = 0; i < 8; ++i) { Cv[i] = t0[i]; Cv[8 + i] = t1[i]; } }
            const float dA = expf(dt * A), dtx = dt * x;
            float y = 0.f;
#pragma unroll
            for (int i = 0; i < 16; ++i) { h[i] = h[i] * dA + dtx * Bv[i]; y += Cv[i] * h[i]; }
            y += __shfl_xor(y, 1); y += __shfl_xor(y, 2); y += __shfl_xor(y, 4);
            if (nq == 0) { const float yo = y + x * Dh; const float zs = bf2f(Z[(size_t)r * IN_PAD + C_ZS + hh * P_SSM + pp]); YG[(size_t)r * DSSM + hh * P_SSM + pp] = (bf16)f2bf(yo * siluf_(zs)); }
        }
        float* so = (smp ? p.out + O_SSSM + ((((size_t)l * DB + bb) * H_SSM + hh) * P_SSM + pp) * N_SSM : p.out + O_PSSM + ((((size_t)l * BATCH + bb) * H_SSM + hh) * P_SSM + pp) * N_SSM) + nq * 16;
#pragma unroll
        for (int i = 0; i < 4; ++i) *(f32x4*)(so + 4 * i) = (f32x4){h[4 * i], h[4 * i + 1], h[4 * i + 2], h[4 * i + 3]};
    }
}
__global__ void __launch_bounds__(256) k_normyg(Params p, long l_) {
    const int l = (int)l_;
    bf16* YG = (bf16*)(p.ws + WS_YG); const float* g = p.in[I_SSN] + (size_t)l * DSSM;
    const int lane = threadIdx.x & 63, gw = (blockIdx.x * blockDim.x + threadIdx.x) >> 6, nw = (gridDim.x * blockDim.x) >> 6;
    for (int r = gw; r < R; r += nw) {
        float v[4][8]; float ss = 0.f;
#pragma unroll
        for (int j = 0; j < 4; ++j) { ld8(YG + (size_t)r * DSSM + lane * 8 + j * 512, v[j]);
#pragma unroll
            for (int i = 0; i < 8; ++i) ss += v[j][i] * v[j][i]; }
        const float rstd = rsqrtf(wave_sum(ss) * (1.f / DSSM) + EPS);
#pragma unroll
        for (int j = 0; j < 4; ++j) { float gg[8]; ld8f(g + lane * 8 + j * 512, gg);
#pragma unroll
            for (int i = 0; i < 8; ++i) v[j][i] = v[j][i] * rstd * gg[i];
            st8(YG + (size_t)r * DSSM + lane * 8 + j * 512, v[j]); }
    }
}

__global__ void __launch_bounds__(256) k_swa(Params p, long l_) {
    const int l = (int)l_;
    const bf16* Z = (const bf16*)(p.ws + WS_Z); const bf16* QR = (const bf16*)(p.ws + WS_B2); const bf16* KR = (const bf16*)(p.ws + WS_KR); bf16* O = (bf16*)(p.ws + WS_B3);
    const int lane = threadIdx.x & 63, gw = (blockIdx.x * blockDim.x + threadIdx.x) >> 6, nw = (gridDim.x * blockDim.x) >> 6;
    for (int unit = gw; unit < R * H_ATT; unit += nw) {
        const int r = unit >> 4, hh = unit & 15, kv = hh >> 2;
        const bool smp = r >= RPROMPT; const int t = smp ? 0 : (r & (SEQ - 1)), bb = r - RPROMPT;
        const float qv = bf2f(QR[(size_t)r * D + hh * HD + lane]);
        const float* ck = p.in[I_SWK] + (((size_t)l * DB + (smp ? bb : 0)) * WINDOW) * KV_ATT * HD;
        const float* cv = p.in[I_SWV] + (((size_t)l * DB + (smp ? bb : 0)) * WINDOW) * KV_ATT * HD;
        float s[2];
#pragma unroll
        for (int half = 0; half < 2; ++half) {
            const int w = lane + 64 * half;
            float kk[64]; bool valid = true;
            if (!smp) { valid = (t - (WINDOW - 1) + w) >= 0;
                const bf16* kr = KR + (size_t)(valid ? r - (WINDOW - 1) + w : r) * 256 + kv * HD;
#pragma unroll
                for (int j = 0; j < 8; ++j) { float tmp[8]; ld8(kr + j * 8, tmp);
#pragma unroll
                    for (int i = 0; i < 8; ++i) kk[j * 8 + i] = tmp[i]; } }
            else if (w < WINDOW - 1) { const float* kr = ck + ((size_t)(w + 1) * KV_ATT + kv) * HD;
#pragma unroll
                for (int j = 0; j < 8; ++j) { float tmp[8]; ld8f(kr + j * 8, tmp);
#pragma unroll
                    for (int i = 0; i < 8; ++i) kk[j * 8 + i] = tmp[i]; } }
            else { const bf16* kr = KR + (size_t)r * 256 + kv * HD;
#pragma unroll
                for (int j = 0; j < 8; ++j) { float tmp[8]; ld8(kr + j * 8, tmp);
#pragma unroll
                    for (int i = 0; i < 8; ++i) kk[j * 8 + i] = tmp[i]; } }
            float acc = 0.f;
#pragma unroll
            for (int d = 0; d < 64; ++d) acc += __shfl(qv, d) * kk[d];
            s[half] = valid ? acc * 0.125f : -INFINITY;
        }
        const float sink = p.in[I_SINK][l * H_ATT + hh];
        const float m = fmaxf(wave_max(fmaxf(s[0], s[1])), sink);
        const float e0 = __expf(s[0] - m), e1 = __expf(s[1] - m);
        const float den = wave_sum(e0 + e1) + __expf(sink - m);
        const float p0 = e0 / den, p1 = e1 / den;
        float o = 0.f;
        for (int w = 0; w < WINDOW; ++w) {
            const float pw = w < 64 ? __shfl(p0, w) : __shfl(p1, w - 64);
            float vv;
            if (!smp) { const bool valid = (t - (WINDOW - 1) + w) >= 0; vv = valid ? bf2f(Z[(size_t)(r - (WINDOW - 1) + w) * IN_PAD + C_V + kv * HD + lane]) : 0.f; }
            else if (w < WINDOW - 1) vv = cv[((size_t)(w + 1) * KV_ATT + kv) * HD + lane];
            else vv = bf2f(Z[(size_t)r * IN_PAD + C_V + kv * HD + lane]);
            o += pw * vv;
        }
        O[(size_t)r * D + hh * HD + lane] = (bf16)f2bf(o);
    }
}

__global__ void __launch_bounds__(256) k_resnorm(Params p, const float* gpost, const float* gnext) {
    const float* OUTF = (const float*)(p.ws + WS_F1); bf16* XN = (bf16*)(p.ws + WS_XN);
    const int lane = threadIdx.x & 63, gw = (blockIdx.x * blockDim.x + threadIdx.x) >> 6, nw = (gridDim.x * blockDim.x) >> 6;
    for (int r = gw; r < R; r += nw) {
        f32x4 v[4], x[4]; float ss = 0.f;
#pragma unroll
        for (int j = 0; j < 4; ++j) { v[j] = *(const f32x4*)(OUTF + (size_t)r * D + lane * 4 + j * 256); ss += v[j].x * v[j].x + v[j].y * v[j].y + v[j].z * v[j].z + v[j].w * v[j].w; }
        const float rstd = rsqrtf(wave_sum(ss) * (1.f / D) + EPS);
        float s2 = 0.f;
#pragma unroll
        for (int j = 0; j < 4; ++j) { const f32x4 gg = *(const f32x4*)(gpost + lane * 4 + j * 256); float* xp = p.out + (size_t)r * D + lane * 4 + j * 256;
            x[j] = *(const f32x4*)xp + v[j] * rstd * gg; *(f32x4*)xp = x[j]; s2 += x[j].x * x[j].x + x[j].y * x[j].y + x[j].z * x[j].z + x[j].w * x[j].w; }
        if (gnext) {
            const float rstd2 = rsqrtf(wave_sum(s2) * (1.f / D) + EPS);
#pragma unroll
            for (int j = 0; j < 4; ++j) { const f32x4 gg = *(const f32x4*)(gnext + lane * 4 + j * 256);
                u32x2 w; w.x = pk2(x[j].x * rstd2 * gg.x, x[j].y * rstd2 * gg.y); w.y = pk2(x[j].z * rstd2 * gg.z, x[j].w * rstd2 * gg.w);
                *(u32x2*)(XN + (size_t)r * D + lane * 4 + j * 256) = w; }
        }
    }
}

__global__ void __launch_bounds__(256) k_xattn(Params p, long l_) {
    const int l = (int)l_;
    const bf16* Q2 = (const bf16*)(p.ws + WS_B1); const bf16* MK = (const bf16*)(p.ws + WS_MK); const bf16* MV = (const bf16*)(p.ws + WS_MV); bf16* O2 = (bf16*)(p.ws + WS_B2);
    const int lane = threadIdx.x & 63, gw = (blockIdx.x * blockDim.x + threadIdx.x) >> 6, nw = (gridDim.x * blockDim.x) >> 6;
    for (int unit = gw; unit < R * XH; unit += nw) {
        const int r = unit >> 2, hh = unit & 3; const bool smp = r >= RPROMPT; const int bb = smp ? r - RPROMPT : r >> 11;
        float q[4]; { const u32x2 w = *(const u32x2*)(Q2 + (size_t)r * D + hh * XHD + lane * 4); q[0] = bf2f(w.x & 0xffffu); q[1] = bf2f(w.x >> 16); q[2] = bf2f(w.y & 0xffffu); q[3] = bf2f(w.y >> 16); }
        const float* ck = p.in[I_CMK] + (((size_t)l * DB + (smp ? bb : 0)) * MEM) * XH * XHD + hh * XHD + lane * 4;
        const float* cv = p.in[I_CMV] + (((size_t)l * DB + (smp ? bb : 0)) * MEM) * XH * XHD + hh * XHD + lane * 4;
        const bf16* mk = MK + ((size_t)(smp ? 0 : bb) * MEM) * D + hh * XHD + lane * 4; const bf16* mv = MV + ((size_t)(smp ? 0 : bb) * MEM) * D + hh * XHD + lane * 4;
        float sc[4];
#pragma unroll
        for (int jo = 0; jo < 4; ++jo) { sc[jo] = 0.f;
            for (int ji = 0; ji < 64; ++ji) { const int key = jo * 64 + ji; float k4[4];
                if (smp) { const f32x4 kv = *(const f32x4*)(ck + (size_t)key * XH * XHD); k4[0] = kv.x; k4[1] = kv.y; k4[2] = kv.z; k4[3] = kv.w; }
                else { const u32x2 w = *(const u32x2*)(mk + (size_t)key * D); k4[0] = bf2f(w.x & 0xffffu); k4[1] = bf2f(w.x >> 16); k4[2] = bf2f(w.y & 0xffffu); k4[3] = bf2f(w.y >> 16); }
                const float s = wave_sum(q[0] * k4[0] + q[1] * k4[1] + q[2] * k4[2] + q[3] * k4[3]) * 0.0625f;
                if (ji == lane) sc[jo] = s; } }
        const float m = wave_max(fmaxf(fmaxf(sc[0], sc[1]), fmaxf(sc[2], sc[3])));
        float e[4]; float es = 0.f;
#pragma unroll
        for (int jo = 0; jo < 4; ++jo) { e[jo] = __expf(sc[jo] - m); es += e[jo]; }
        const float inv = 1.f / wave_sum(es);
        float o[4] = {0.f, 0.f, 0.f, 0.f};
#pragma unroll
        for (int jo = 0; jo < 4; ++jo)
            for (int ji = 0; ji < 64; ++ji) { const int key = jo * 64 + ji; const float pk = __shfl(e[jo], ji) * inv; float v4[4];
                if (smp) { const f32x4 vv = *(const f32x4*)(cv + (size_t)key * XH * XHD); v4[0] = vv.x; v4[1] = vv.y; v4[2] = vv.z; v4[3] = vv.w; }
                else { const u32x2 w = *(const u32x2*)(mv + (size_t)key * D); v4[0] = bf2f(w.x & 0xffffu); v4[1] = bf2f(w.x >> 16); v4[2] = bf2f(w.y & 0xffffu); v4[3] = bf2f(w.y >> 16); }
                o[0] += pk * v4[0]; o[1] += pk * v4[1]; o[2] += pk * v4[2]; o[3] += pk * v4[3]; }
        u32x2 w; w.x = pk2(o[0], o[1]); w.y = pk2(o[2], o[3]); *(u32x2*)(O2 + (size_t)r * D + hh * XHD + lane * 4) = w;
    }
}

__global__ void __launch_bounds__(256) k_ffnconv(Params p, long l_) {
    const int l = (int)l_;
    const bf16* AG = (const bf16*)(p.ws + WS_AG); bf16* HID = (bf16*)(p.ws + WS_HID);
    const float* cw = p.in[I_FCW] + (size_t)l * 3 * DFF; const float* cb = p.in[I_FCB] + (size_t)l * DFF;
    const int nitems = R * (DFF / 8);
    for (int it = blockIdx.x * blockDim.x + threadIdx.x; it < nitems; it += gridDim.x * blockDim.x) {
        const int r = it / (DFF / 8), c0 = (it % (DFF / 8)) * 8;
        float x[3][8], g[8], c[8], acc[8];
        const bf16* ar = AG + (size_t)r * 2 * DFF + c0;
        ld8(ar, x[2]); ld8(ar + DFF, g);
        if (r < RPROMPT) {
            const int t = r & (SEQ - 1);
#pragma unroll
            for (int k = 0; k < 2; ++k) {
                if (t - 2 + k >= 0) ld8(ar - (size_t)(2 - k) * 2 * DFF, x[k]);
                else {
#pragma unroll
                    for (int i = 0; i < 8; ++i) x[k][i] = 0.f; }
            }
            if (t >= SEQ - 2) st8f(p.out + O_PFC + (((size_t)l * BATCH + (r >> 11)) * 2 + (t - (SEQ - 2))) * DFF + c0, x[2]);
        } else {
            const int bb = r - RPROMPT; const float* buf = p.in[I_SFC] + ((size_t)l * DB + bb) * 2 * DFF;
            ld8f(buf + c0, x[0]); ld8f(buf + DFF + c0, x[1]);
            float* so = p.out + O_SFC + ((size_t)l * DB + bb) * 2 * DFF;
            st8f(so + c0, x[1]); st8f(so + DFF + c0, x[2]);
        }
        ld8f(cb + c0, acc);
#pragma unroll
        for (int k = 0; k < 3; ++k) { ld8f(cw + (size_t)k * DFF + c0, c);
#pragma unroll
            for (int i = 0; i < 8; ++i) acc[i] += c[i] * x[k][i]; }
#pragma unroll
        for (int i = 0; i < 8; ++i) acc[i] = siluf_(acc[i]) * g[i];
        st8(HID + (size_t)r * DFF + c0, acc);
    }
}

extern "C" void kernel_launch(void* const* d_in, const int* in_sizes, int n_in, void* d_out, int out_size, void* d_ws, size_t ws_size, hipStream_t stream) {
    if (n_in != N_IN || (size_t)out_size != O_END || ws_size < WS_END) { fprintf(stderr, "kernel_launch: unexpected shapes (n_in %d out %d ws %zu)\n", n_in, out_size, ws_size); return; }
    Params p{};
    for (int i = 0; i < N_IN; ++i) p.in[i] = (const float*)d_in[i];
    p.out = (float*)d_out; p.ws = (unsigned char*)d_ws;
    unsigned char* ws = p.ws;
    const int G = 2048;
    for (int l = 0; l < DEPTH; ++l) {
        unsigned char* wl = ws + WS_W + l * W_LAYER;
        hipMemsetAsync(wl + W_IN + (size_t)IN_DIM * D * 2, 0, (size_t)(IN_PAD - IN_DIM) * D * 2, stream);
        k_wconv<<<G, 256, 0, stream>>>(p.in[I_WIN] + (size_t)l * D * IN_DIM, D, IN_DIM, (bf16*)(wl + W_IN), 0);
        k_wconv<<<G, 256, 0, stream>>>(p.in[I_WAO] + (size_t)l * D * D, D, D, (bf16*)(wl + W_A), 0);
        k_wconv<<<G, 256, 0, stream>>>(p.in[I_WSO] + (size_t)l * DSSM * D, DSSM, D, (bf16*)(wl + W_SSM), 0);
        k_wconv<<<G, 256, 0, stream>>>(p.in[I_WATT] + (size_t)l * D * D, D, D, (bf16*)(wl + W_ATT), 0);
        k_wconv<<<G, 256, 0, stream>>>(p.in[I_WOUT] + (size_t)l * D * D, D, D, (bf16*)(wl + W_OUT), 0);
        k_wconv<<<G, 256, 0, stream>>>(p.in[I_WXQ] + (size_t)l * D * D, D, D, (bf16*)(wl + W_XQ), 0);
        k_wconv<<<G, 256, 0, stream>>>(p.in[I_WXK] + (size_t)l * D * D, D, D, (bf16*)(wl + W_XKV), 0);
        k_wconv<<<G, 256, 0, stream>>>(p.in[I_WXV] + (size_t)l * D * D, D, D, (bf16*)(wl + W_XKV), D);
        k_wconv<<<G, 256, 0, stream>>>(p.in[I_WXO] + (size_t)l * D * D, D, D, (bf16*)(wl + W_XO), 0);
        k_wconv<<<G, 256, 0, stream>>>(p.in[I_WFI] + (size_t)l * D * 2 * DFF, D, 2 * DFF, (bf16*)(wl + W_FFI), 0);
        k_wconv<<<G, 256, 0, stream>>>(p.in[I_WFO] + (size_t)l * DFF * D, DFF, D, (bf16*)(wl + W_FFO), 0);
    }
    hipMemsetAsync(ws + WS_XN + (size_t)R * D * 2, 0, (size_t)(RPAD - R) * D * 2, stream);
    k_xinit<<<G, 256, 0, stream>>>(p);
    bf16 *Z = (bf16*)(ws + WS_Z), *XBC = (bf16*)(ws + WS_XBC), *YG = (bf16*)(ws + WS_YG), *XN = (bf16*)(ws + WS_XN), *B1 = (bf16*)(ws + WS_B1), *B2 = (bf16*)(ws + WS_B2), *B3 = (bf16*)(ws + WS_B3), *B4 = (bf16*)(ws + WS_B4);
    bf16 *AG = (bf16*)(ws + WS_AG), *HID = (bf16*)(ws + WS_HID), *MN = (bf16*)(ws + WS_MN), *MK = (bf16*)(ws + WS_MK), *MV = (bf16*)(ws + WS_MV);
    float *F0 = (float*)(ws + WS_F0), *F1 = (float*)(ws + WS_F1);
    (void)XBC;
    for (int l = 0; l < DEPTH; ++l) {
        unsigned char* wl = ws + WS_W + l * W_LAYER;
        k_normrows<<<G, 256, 0, stream>>>(p.in[I_MEM], BATCH * MEM, p.in[I_NMEM] + (size_t)l * D, MN);
        k_gemm<EpiStoreBf16><<<G, 256, 0, stream>>>(XN, D, (const bf16*)(wl + W_IN), D, RPAD, IN_PAD, EpiStoreBf16{Z, IN_PAD});
        k_gemm<EpiMemKV><<<G, 256, 0, stream>>>(MN, D, (const bf16*)(wl + W_XKV), D, BATCH * MEM, 2 * D,
            EpiMemKV{p.out + O_PMK + (size_t)l * BATCH * MEM * D, p.out + O_PMV + (size_t)l * BATCH * MEM * D, MK, MV});
        k_mixa<<<G, 256, 0, stream>>>(p, l);
        k_ssmconv<<<G, 256, 0, stream>>>(p, l);
        k_dt<<<G, 256, 0, stream>>>(p, l);
        k_rope<<<G, 256, 0, stream>>>(p, l);
        k_swashift<<<G, 256, 0, stream>>>(p, l);
        k_ssd<<<BATCH * H_SSM + DB * H_SSM, 512, 0, stream>>>(p, l);
        k_swa<<<G * 4, 256, 0, stream>>>(p, l);
        k_normyg<<<G, 256, 0, stream>>>(p, l);
        k_gemm<EpiGate<0>><<<G, 256, 0, stream>>>(B1, D, (const bf16*)(wl + W_A), D, RPAD, D, EpiGate<0>{Z, F0, B4});
        k_gemm<EpiGate<1>><<<G, 256, 0, stream>>>(YG, DSSM, (const bf16*)(wl + W_SSM), DSSM, RPAD, D, EpiGate<1>{Z, F0, B4});
        k_gemm<EpiGate<2>><<<G, 256, 0, stream>>>(B3, D, (const bf16*)(wl + W_ATT), D, RPAD, D, EpiGate<2>{Z, F0, B4});
        k_gemm<EpiStoreF32><<<G, 256, 0, stream>>>(B4, D, (const bf16*)(wl + W_OUT), D, RPAD, D, EpiStoreF32{F1, D});
        k_resnorm<<<G, 256, 0, stream>>>(p, p.in[I_NMPOST] + (size_t)l * D, p.in[I_NXPRE] + (size_t)l * D);
        k_gemm<EpiStoreBf16><<<G, 256, 0, stream>>>(XN, D, (const bf16*)(wl + W_XQ), D, RPAD, D, EpiStoreBf16{B1, D});
        k_xattn<<<G * 4, 256, 0, stream>>>(p, l);
        k_gemm<EpiStoreF32><<<G, 256, 0, stream>>>(B2, D, (const bf16*)(wl + W_XO), D, RPAD, D, EpiStoreF32{F1, D});
        k_resnorm<<<G, 256, 0, stream>>>(p, p.in[I_NXPOST] + (size_t)l * D, p.in[I_NFPRE] + (size_t)l * D);
        k_gemm<EpiStoreBf16><<<G, 256, 0, stream>>>(XN, D, (const bf16*)(wl + W_FFI), D, RPAD, 2 * DFF, EpiStoreBf16{AG, 2 * DFF});
        k_ffnconv<<<G, 256, 0, stream>>>(p, l);
        k_gemm<EpiStoreF32><<<G, 256, 0, stream>>>(HID, DFF, (const bf16*)(wl + W_FFO), DFF, RPAD, D, EpiStoreF32{F1, D});
        k_resnorm<<<G, 256, 0, stream>>>(p, p.in[I_NFPOST] + (size_t)l * D, l + 1 < DEPTH ? p.in[I_NMPRE] + (size_t)(l + 1) * D : nullptr);
    }
}
```

```cpp
#include <hip/hip_runtime.h>
#include <cstdio>
#include <cstdint>

typedef unsigned short bf16;
typedef float f32x4 __attribute__((ext_vector_type(4)));
typedef unsigned u32x4 __attribute__((ext_vector_type(4)));
typedef unsigned u32x2 __attribute__((ext_vector_type(2)));

constexpr int D = 1024, BATCH = 8, SEQ = 2048, DEPTH = 2, DB = 128;
constexpr int RPROMPT = BATCH * SEQ;
constexpr int R = RPROMPT + DB;
constexpr int RPAD = 16640;
constexpr int DSSM = 2048, H_SSM = 32, P_SSM = 64, G_SSM = 8, N_SSM = 128, CD = 4096;
constexpr int H_ATT = 16, KV_ATT = 4, HD = 64, WINDOW = 128;
constexpr int MEM = 256, XH = 4, XHD = 256;
constexpr int DFF = 2816;
constexpr int IN_DIM = 13856, IN_PAD = 14080;
constexpr int PAST_LEN = 8192;
constexpr float EPS = 1e-6f;
constexpr int C_VA = 0, C_GB = 1024, C_GC = 2048, C_ZS = 3072, C_XBC = 5120, C_DT = 9216, C_Q = 9248, C_K = 10272, C_V = 10528, C_G = 10784;
static_assert(C_G + 3 * D == IN_DIM, "in-proj partition");

enum { I_XP = 0, I_XS, I_MEM, I_SCA, I_SSC, I_SSM, I_SWK, I_SWV, I_CMK, I_CMV, I_SFC, I_NMPRE, I_NMPOST, I_WIN, I_CAW, I_WAO, I_SCW, I_SCB, I_DTB, I_ALOG, I_SSD,
       I_SSN, I_WSO, I_SINK, I_WATT, I_WOUT, I_NXPRE, I_NXPOST, I_NMEM, I_WXQ, I_WXK, I_WXV, I_WXO, I_NFPRE, I_NFPOST, I_WFI, I_FCW, I_FCB, I_WFO, N_IN };
static_assert(N_IN == 39, "39 inputs");

constexpr size_t O_YP = 0, O_YS = 16777216, O_PCA = 16908288, O_PSC = 16941056, O_PSSM = 17137664, O_PSWK = 21331968, O_PSWV = 21856256, O_PFC = 22380544,
                 O_PMK = 22470656, O_PMV = 26664960, O_SCA = 30859264, O_SSC = 31383552, O_SSSM = 34529280, O_SSWK = 101638144, O_SSWV = 110026752, O_SFC = 118415360,
                 O_END = 119857152;

constexpr size_t MiB = 1u << 20;
constexpr size_t WS_CTL = 0;
constexpr size_t WS_W = 2 * MiB, W_LAYER = 64 * MiB;
constexpr size_t W_IN = 0, W_A = 28 * MiB, W_SSM = 30 * MiB, W_ATT = 34 * MiB, W_OUT = 36 * MiB, W_XQ = 38 * MiB, W_XKV = 40 * MiB, W_XO = 44 * MiB, W_FFI = 46 * MiB, W_FFO = 58 * MiB;
constexpr size_t WS_Z = 130 * MiB;
constexpr size_t WS_AG = WS_Z;
constexpr size_t WS_HID = WS_Z + 180 * MiB;
constexpr size_t WS_XBC = 578 * MiB;
constexpr size_t WS_YG = 708 * MiB;
constexpr size_t WS_XN = 773 * MiB;
constexpr size_t WS_B1 = 806 * MiB;
constexpr size_t WS_B2 = 839 * MiB;
constexpr size_t WS_B3 = 872 * MiB;
constexpr size_t WS_B4 = 905 * MiB;
constexpr size_t WS_F0 = 938 * MiB;
constexpr size_t WS_F1 = 1003 * MiB;
constexpr size_t WS_KR = 1068 * MiB;
constexpr size_t WS_DT = 1077 * MiB;
constexpr size_t WS_MN = 1080 * MiB, WS_MK = 1084 * MiB, WS_MV = 1088 * MiB;
constexpr size_t WS_END = 1092 * MiB;
static_assert((size_t)RPAD * IN_PAD * 2 <= 448 * MiB && (size_t)RPAD * 2 * DFF * 2 <= 180 * MiB && WS_HID + (size_t)RPAD * DFF * 2 <= WS_XBC, "ws map");

struct Params { const float* in[N_IN]; float* out; unsigned char* ws; };

__device__ __forceinline__ float bf2f(unsigned v) { return __uint_as_float(v << 16); }
__device__ __forceinline__ unsigned f2bf(float f) { unsigned u = __float_as_uint(f); return (u + 0x7fffu + ((u >> 16) & 1u)) >> 16; }
__device__ __forceinline__ unsigned pk2(float lo, float hi) { return f2bf(lo) | (f2bf(hi) << 16); }
__device__ __forceinline__ void ld8(const bf16* p, float (&o)[8]) {
    const u32x4 w = *(const u32x4*)p;
    o[0] = bf2f(w.x & 0xffffu); o[1] = bf2f(w.x >> 16); o[2] = bf2f(w.y & 0xffffu); o[3] = bf2f(w.y >> 16);
    o[4] = bf2f(w.z & 0xffffu); o[5] = bf2f(w.z >> 16); o[6] = bf2f(w.w & 0xffffu); o[7] = bf2f(w.w >> 16);
}
__device__ __forceinline__ void st8(bf16* p, const float (&v)[8]) {
    u32x4 w; w.x = pk2(v[0], v[1]); w.y = pk2(v[2], v[3]); w.z = pk2(v[4], v[5]); w.w = pk2(v[6], v[7]); *(u32x4*)p = w;
}
__device__ __forceinline__ void ld8f(const float* p, float (&o)[8]) {
    const f32x4 a = *(const f32x4*)p, b = *(const f32x4*)(p + 4);
    o[0] = a.x; o[1] = a.y; o[2] = a.z; o[3] = a.w; o[4] = b.x; o[5] = b.y; o[6] = b.z; o[7] = b.w;
}
__device__ __forceinline__ void st8f(float* p, const float (&v)[8]) {
    *(f32x4*)p = (f32x4){v[0], v[1], v[2], v[3]}; *(f32x4*)(p + 4) = (f32x4){v[4], v[5], v[6], v[7]};
}
__device__ __forceinline__ float wave_sum(float v) {
#pragma unroll
    for (int o = 1; o < 64; o <<= 1) v += __shfl_xor(v, o);
    return v;
}
__device__ __forceinline__ float wave_max(float v) {
#pragma unroll
    for (int o = 1; o < 64; o <<= 1) v = fmaxf(v, __shfl_xor(v, o));
    return v;
}
__device__ __forceinline__ int tid_opaque() { int t = threadIdx.x; asm volatile("" : "+v"(t)); return t; }
__device__ __forceinline__ float sigmoidf_(float x) { return 1.f / (1.f + __expf(-x)); }
__device__ __forceinline__ float siluf_(float x) { return x / (1.f + __expf(-x)); }
__device__ __forceinline__ float softplusf_(float x) { return x > 20.f ? x : log1pf(expf(x)); }

__device__ __forceinline__ void ph_xinit(const Params& p) {
    const int tidx = tid_opaque();
    const int lane = tidx & 63, gw = (blockIdx.x * blockDim.x + tidx) >> 6, nw = (gridDim.x * blockDim.x) >> 6;
    bf16* XN = (bf16*)(p.ws + WS_XN); const float* g = p.in[I_NMPRE];
    for (int r = gw; r < R; r += nw) {
        const float* src = r < RPROMPT ? p.in[I_XP] + (size_t)r * D : p.in[I_XS] + (size_t)(r - RPROMPT) * D;
        f32x4 v[4]; float ss = 0.f;
#pragma unroll
        for (int j = 0; j < 4; ++j) { v[j] = *(const f32x4*)(src + lane * 4 + j * 256); ss += v[j].x * v[j].x + v[j].y * v[j].y + v[j].z * v[j].z + v[j].w * v[j].w;
            *(f32x4*)(p.out + (size_t)r * D + lane * 4 + j * 256) = v[j]; }
        const float rstd = rsqrtf(wave_sum(ss) * (1.f / D) + EPS);
#pragma unroll
        for (int j = 0; j < 4; ++j) { const f32x4 gg = *(const f32x4*)(g + lane * 4 + j * 256);
            u32x2 w; w.x = pk2(v[j].x * rstd * gg.x, v[j].y * rstd * gg.y); w.y = pk2(v[j].z * rstd * gg.z, v[j].w * rstd * gg.w);
            *(u32x2*)(XN + (size_t)r * D + lane * 4 + j * 256) = w; }
    }
}
__device__ __forceinline__ void ph_normrows(const float* src, const int rows, const float* g, bf16* dst) {
    const int tidx = tid_opaque();
    const int lane = tidx & 63, gw = (blockIdx.x * blockDim.x + tidx) >> 6, nw = (gridDim.x * blockDim.x) >> 6;
    for (int r = gw; r < rows; r += nw) {
        f32x4 v[4]; float ss = 0.f;
#pragma unroll
        for (int j = 0; j < 4; ++j) { v[j] = *(const f32x4*)(src + (size_t)r * D + lane * 4 + j * 256); ss += v[j].x * v[j].x + v[j].y * v[j].y + v[j].z * v[j].z + v[j].w * v[j].w; }
        const float rstd = rsqrtf(wave_sum(ss) * (1.f / D) + EPS);
#pragma unroll
        for (int j = 0; j < 4; ++j) { const f32x4 gg = *(const f32x4*)(g + lane * 4 + j * 256);
            u32x2 w; w.x = pk2(v[j].x * rstd * gg.x, v[j].y * rstd * gg.y); w.y = pk2(v[j].z * rstd * gg.z, v[j].w * rstd * gg.w);
            *(u32x2*)(dst + (size_t)r * D + lane * 4 + j * 256) = w; }
    }
}

struct EpiStoreBf16 { bf16* O; long ldo; __device__ __forceinline__ void operator()(int row, int col, f32x4 v) const {
    u32x2 w; w.x = pk2(v.x, v.y); w.y = pk2(v.z, v.w); *(u32x2*)(O + (size_t)row * ldo + col) = w; } };
struct EpiStoreF32 { float* O; long ldo; __device__ __forceinline__ void operator()(int row, int col, f32x4 v) const { *(f32x4*)(O + (size_t)row * ldo + col) = v; } };
struct EpiMemKV { float* outk; float* outv; bf16* MK; bf16* MV; __device__ __forceinline__ void operator()(int row, int col, f32x4 v) const {
    u32x2 w; w.x = pk2(v.x, v.y); w.y = pk2(v.z, v.w);
    if (col < 1024) { *(f32x4*)(outk + (size_t)row * 1024 + col) = v; *(u32x2*)(MK + (size_t)row * 1024 + col) = w; }
    else { *(f32x4*)(outv + (size_t)row * 1024 + col - 1024) = v; *(u32x2*)(MV + (size_t)row * 1024 + col - 1024) = w; } } };
template <int WHICH> struct EpiGate { const bf16* Z; float* MIXF; bf16* MIX; __device__ __forceinline__ void operator()(int row, int col, f32x4 v) const {
    const u32x2 gz = *(const u32x2*)(Z + (size_t)row * IN_PAD + C_G + WHICH * D + col);
    f32x4 g; g.x = sigmoidf_(bf2f(gz.x & 0xffffu)); g.y = sigmoidf_(bf2f(gz.x >> 16)); g.z = sigmoidf_(bf2f(gz.y & 0xffffu)); g.w = sigmoidf_(bf2f(gz.y >> 16));
    f32x4 t = g * v; float* mp = MIXF + (size_t)row * D + col;
    if (WHICH > 0) t += *(const f32x4*)mp;
    if (WHICH < 2) *(f32x4*)mp = t;
    else { u32x2 w; w.x = pk2(t.x, t.y); w.y = pk2(t.z, t.w); *(u32x2*)(MIX + (size_t)row * D + col) = w; } } };

__device__ __forceinline__ void ph_mixa(const Params& p, const int l) {
    const int tidx = tid_opaque();
    const bf16* Z = (const bf16*)(p.ws + WS_Z); bf16* UA = (bf16*)(p.ws + WS_B1);
    const float* cw = p.in[I_CAW] + (size_t)l * 3 * D;
    const int nitems = R * 128;
    for (int it = blockIdx.x * blockDim.x + tidx; it < nitems; it += gridDim.x * blockDim.x) {
        const int r = it >> 7, c0 = (it & 127) * 8;
        float w0[8], w1[8], w2[8], a[8], b[8], gb[8], c[3][8], u[8];
        const bf16* zr = Z + (size_t)r * IN_PAD;
        ld8(zr + C_GC + c0, a); ld8(zr + C_VA + c0, b); ld8(zr + C_GB + c0, gb);
#pragma unroll
        for (int i = 0; i < 8; ++i) w2[i] = a[i] * b[i];
        if (r < RPROMPT) {
            const int t = r & (SEQ - 1);
            if (t >= 1) { ld8(zr - IN_PAD + C_GC + c0, a); ld8(zr - IN_PAD + C_VA + c0, b);
#pragma unroll
                for (int i = 0; i < 8; ++i) w1[i] = a[i] * b[i]; }
            else {
#pragma unroll
                for (int i = 0; i < 8; ++i) w1[i] = 0.f; }
            if (t >= 2) { ld8(zr - 2 * IN_PAD + C_GC + c0, a); ld8(zr - 2 * IN_PAD + C_VA + c0, b);
#pragma unroll
                for (int i = 0; i < 8; ++i) w0[i] = a[i] * b[i]; }
            else {
#pragma unroll
                for (int i = 0; i < 8; ++i) w0[i] = 0.f; }
            if (t >= SEQ - 2) st8f(p.out + O_PCA + (((size_t)l * BATCH + (r >> 11)) * 2 + (t - (SEQ - 2))) * D + c0, w2);
        } else {
            const int bb = r - RPROMPT; const float* buf = p.in[I_SCA] + ((size_t)l * DB + bb) * 2 * D;
            ld8f(buf + c0, w0); ld8f(buf + D + c0, w1);
            float* so = p.out + O_SCA + ((size_t)l * DB + bb) * 2 * D;
            st8f(so + c0, w1); st8f(so + D + c0, w2);
        }
        ld8f(cw + c0, c[0]); ld8f(cw + D + c0, c[1]); ld8f(cw + 2 * D + c0, c[2]);
#pragma unroll
        for (int i = 0; i < 8; ++i) u[i] = gb[i] * (c[0][i] * w0[i] + c[1][i] * w1[i] + c[2][i] * w2[i]);
        st8(UA + (size_t)r * D + c0, u);
    }
}
__device__ __forceinline__ void ph_ssmconv(const Params& p, const int l) {
    const int tidx = tid_opaque();
    const bf16* Z = (const bf16*)(p.ws + WS_Z); bf16* XBC = (bf16*)(p.ws + WS_XBC);
    const float* cw = p.in[I_SCW] + (size_t)l * 4 * CD; const float* cb = p.in[I_SCB] + (size_t)l * CD;
    const int nitems = R * (CD / 8);
    for (int it = blockIdx.x * blockDim.x + tidx; it < nitems; it += gridDim.x * blockDim.x) {
        const int r = it / (CD / 8), c0 = (it % (CD / 8)) * 8;
        float x[4][8], c[8], acc[8];
        const bf16* zr = Z + (size_t)r * IN_PAD + C_XBC + c0;
        ld8(zr, x[3]);
        if (r < RPROMPT) {
            const int t = r & (SEQ - 1);
#pragma unroll
            for (int k = 0; k < 3; ++k) {
                if (t - 3 + k >= 0) ld8(zr - (size_t)(3 - k) * IN_PAD, x[k]);
                else {
#pragma unroll
                    for (int i = 0; i < 8; ++i) x[k][i] = 0.f; }
            }
            if (t >= SEQ - 3) st8f(p.out + O_PSC + (((size_t)l * BATCH + (r >> 11)) * 3 + (t - (SEQ - 3))) * CD + c0, x[3]);
        } else {
            const int bb = r - RPROMPT; const float* buf = p.in[I_SSC] + ((size_t)l * DB + bb) * 3 * CD;
            ld8f(buf + c0, x[0]); ld8f(buf + CD + c0, x[1]); ld8f(buf + 2 * CD + c0, x[2]);
            float* so = p.out + O_SSC + ((size_t)l * DB + bb) * 3 * CD;
            st8f(so + c0, x[1]); st8f(so + CD + c0, x[2]); st8f(so + 2 * CD + c0, x[3]);
        }
        ld8f(cb + c0, acc);
#pragma unroll
        for (int k = 0; k < 4; ++k) { ld8f(cw + (size_t)k * CD + c0, c);
#pragma unroll
            for (int i = 0; i < 8; ++i) acc[i] += c[i] * x[k][i]; }
#pragma unroll
        for (int i = 0; i < 8; ++i) acc[i] = siluf_(acc[i]);
        st8(XBC + (size_t)r * CD + c0, acc);
    }
}
__device__ __forceinline__ void ph_dt(const Params& p, const int l) {
    const int tidx = tid_opaque();
    const bf16* Z = (const bf16*)(p.ws + WS_Z); float* DT = (float*)(p.ws + WS_DT);
    const float* dtb = p.in[I_DTB] + l * H_SSM;
    for (int it = blockIdx.x * blockDim.x + tidx; it < R * H_SSM; it += gridDim.x * blockDim.x) {
        const int r = it >> 5, h = it & 31;
        DT[it] = softplusf_(bf2f(Z[(size_t)r * IN_PAD + C_DT + h]) + dtb[h]);
    }
}
__constant__ float c_inv_freq[8] = {1.0f, 0.19392274474868576f, 0.03760603093086393f, 0.007292664737217109f, 0.001414213562373095f, 0.0002742481756762073f, 5.318295896944988e-05f, 1.031338537721246e-05f};
__device__ __forceinline__ void ph_rope(const Params& p, const int l) {
    const int tidx = tid_opaque();
    const bf16* Z = (const bf16*)(p.ws + WS_Z); bf16* QR = (bf16*)(p.ws + WS_B2); bf16* KR = (bf16*)(p.ws + WS_KR);
    for (int it = blockIdx.x * blockDim.x + tidx; it < R * 20; it += gridDim.x * blockDim.x) {
        const int r = it / 20, hs = it % 20;
        const bool isq = hs < 16; const int hh = isq ? hs : hs - 16;
        const bf16* src = Z + (size_t)r * IN_PAD + (isq ? C_Q : C_K) + hh * HD;
        bf16* dst = isq ? QR + (size_t)r * D + hh * HD : KR + (size_t)r * 256 + hh * HD;
        const int t = r < RPROMPT ? (r & (SEQ - 1)) : 0;
        const float pos = r < RPROMPT ? (float)t : (float)PAST_LEN;
        float v[8][8];
#pragma unroll
        for (int j = 0; j < 8; ++j) ld8(src + j * 8, v[j]);
        float x1[8], x2[8];
#pragma unroll
        for (int i = 0; i < 8; ++i) { float sn, cs; sincosf(pos * c_inv_freq[i], &sn, &cs); x1[i] = v[0][i] * cs - v[1][i] * sn; x2[i] = v[1][i] * cs + v[0][i] * sn; }
#pragma unroll
        for (int i = 0; i < 8; ++i) { v[0][i] = x1[i]; v[1][i] = x2[i]; }
#pragma unroll
        for (int j = 0; j < 8; ++j) st8(dst + j * 8, v[j]);
        if (!isq) {
            float vv[8][8];
#pragma unroll
            for (int j = 0; j < 8; ++j) ld8(Z + (size_t)r * IN_PAD + C_V + hh * HD + j * 8, vv[j]);
            float* ok = nullptr; float* ov = nullptr;
            if (r < RPROMPT) { if (t >= SEQ - WINDOW) { const size_t o = ((((size_t)l * BATCH + (r >> 11)) * WINDOW + (t - (SEQ - WINDOW))) * KV_ATT + hh) * HD; ok = p.out + O_PSWK + o; ov = p.out + O_PSWV + o; } }
            else { const size_t o = ((((size_t)l * DB + (r - RPROMPT)) * WINDOW + (WINDOW - 1)) * KV_ATT + hh) * HD; ok = p.out + O_SSWK + o; ov = p.out + O_SSWV + o; }
            if (ok) {
#pragma unroll
                for (int j = 0; j < 8; ++j) { st8f(ok + j * 8, v[j]); st8f(ov + j * 8, vv[j]); }
            }
        }
    }
}
__device__ __forceinline__ void ph_swashift(const Params& p, const int l) {
    const int tidx = tid_opaque();
    const size_t per_b = (size_t)WINDOW * KV_ATT * HD, n4 = (size_t)DB * (WINDOW - 1) * KV_ATT * HD / 4, row4 = (size_t)(WINDOW - 1) * KV_ATT * HD / 4;
    const float* ck = p.in[I_SWK] + (size_t)l * DB * per_b; const float* cv = p.in[I_SWV] + (size_t)l * DB * per_b;
    float* ok = p.out + O_SSWK + (size_t)l * DB * per_b; float* ov = p.out + O_SSWV + (size_t)l * DB * per_b;
    for (size_t i = blockIdx.x * (size_t)blockDim.x + tidx; i < n4; i += (size_t)gridDim.x * blockDim.x) {
        const size_t b = i / row4, j = i % row4;
        *(f32x4*)(ok + b * per_b + j * 4) = *(const f32x4*)(ck + b * per_b + KV_ATT * HD + j * 4);
        *(f32x4*)(ov + b * per_b + j * 4) = *(const f32x4*)(cv + b * per_b + KV_ATT * HD + j * 4);
    }
}

__device__ __forceinline__ void ph_ssd(const Params& p, const int l) {
    const int tidx = tid_opaque();
    const bf16* Z = (const bf16*)(p.ws + WS_Z); const bf16* XBC = (const bf16*)(p.ws + WS_XBC); const float* DT = (const float*)(p.ws + WS_DT); bf16* YG = (bf16*)(p.ws + WS_YG);
    const int tid = tidx, pp = tid >> 3, nq = tid & 7;
    const int nunits = BATCH * H_SSM + DB * H_SSM;
    for (int unit = blockIdx.x; unit < nunits; unit += gridDim.x) {
        const bool smp = unit >= BATCH * H_SSM;
        const int bb = smp ? (unit - BATCH * H_SSM) / H_SSM : unit / H_SSM, hh = unit % H_SSM, g = hh >> 2;
        const float A = -expf(p.in[I_ALOG][l * H_SSM + hh]), Dh = p.in[I_SSD][l * H_SSM + hh];
        float h[16];
        if (smp) { const float* s0 = p.in[I_SSM] + ((((size_t)l * DB + bb) * H_SSM + hh) * P_SSM + pp) * N_SSM + nq * 16;
#pragma unroll
            for (int i = 0; i < 4; ++i) { const f32x4 v = *(const f32x4*)(s0 + 4 * i); h[4 * i] = v.x; h[4 * i + 1] = v.y; h[4 * i + 2] = v.z; h[4 * i + 3] = v.w; } }
        else {
#pragma unroll
            for (int i = 0; i < 16; ++i) h[i] = 0.f; }
        const int r0 = smp ? RPROMPT + bb : bb * SEQ, L = smp ? 1 : SEQ;
        for (int t = 0; t < L; ++t) {
            const int r = r0 + t;
            const bf16* xr = XBC + (size_t)r * CD;
            const float x = bf2f(xr[hh * P_SSM + pp]), dt = DT[r * H_SSM + hh];
            float Bv[16], Cv[16];
            { float t0[8], t1[8]; ld8(xr + DSSM + g * N_SSM + nq * 16, t0); ld8(xr + DSSM + g * N_SSM + nq * 16 + 8, t1);
#pragma unroll
              for (int i = 0; i < 8; ++i) { Bv[i] = t0[i]; Bv[8 + i] = t1[i]; }
              ld8(xr + DSSM + G_SSM * N_SSM + g * N_SSM + nq * 16, t0); ld8(xr + DSSM + G_SSM * N_SSM + g * N_SSM + nq * 16 + 8, t1);
#pragma unroll
              for (int i = 0; i < 8; ++i) { Cv[i] = t0[i]; Cv[8 + i] = t1[i]; } }
            const float dA = expf(dt * A), dtx = dt * x;
            float y = 0.f;
#pragma unroll
            for (int i = 0; i < 16; ++i) { h[i] = h[i] * dA + dtx * Bv[i]; y += Cv[i] * h[i]; }
            y += __shfl_xor(y, 1); y += __shfl_xor(y, 2); y += __shfl_xor(y, 4);
            if (nq == 0) { const float yo = y + x * Dh; const float zs = bf2f(Z[(size_t)r * IN_PAD + C_ZS + hh * P_SSM + pp]); YG[(size_t)r * DSSM + hh * P_SSM + pp] = (bf16)f2bf(yo * siluf_(zs)); }
        }
        float* so = (smp ? p.out + O_SSSM + ((((size_t)l * DB + bb) * H_SSM + hh) * P_SSM + pp) * N_SSM : p.out + O_PSSM + ((((size_t)l * BATCH + bb) * H_SSM + hh) * P_SSM + pp) * N_SSM) + nq * 16;
#pragma unroll
        for (int i = 0; i < 4; ++i) *(f32x4*)(so + 4 * i) = (f32x4){h[4 * i], h[4 * i + 1], h[4 * i + 2], h[4 * i + 3]};
    }
}
__device__ __forceinline__ void ph_normyg(const Params& p, const int l) {
    const int tidx = tid_opaque();
    bf16* YG = (bf16*)(p.ws + WS_YG); const float* g = p.in[I_SSN] + (size_t)l * DSSM;
    const int lane = tidx & 63, gw = (blockIdx.x * blockDim.x + tidx) >> 6, nw = (gridDim.x * blockDim.x) >> 6;
    for (int r = gw; r < R; r += nw) {
        float v[4][8]; float ss = 0.f;
#pragma unroll
        for (int j = 0; j < 4; ++j) { ld8(YG + (size_t)r * DSSM + lane * 8 + j * 512, v[j]);
#pragma unroll
            for (int i = 0; i < 8; ++i) ss += v[j][i] * v[j][i]; }
        const float rstd = rsqrtf(wave_sum(ss) * (1.f / DSSM) + EPS);
#pragma unroll
        for (int j = 0; j < 4; ++j) { float gg[8]; ld8f(g + lane * 8 + j * 512, gg);
#pragma unroll
            for (int i = 0; i < 8; ++i) v[j][i] = v[j][i] * rstd * gg[i];
            st8(YG + (size_t)r * DSSM + lane * 8 + j * 512, v[j]); }
    }
}

__device__ __forceinline__ void ph_swa(const Params& p, const int l) {
    const int tidx = tid_opaque();
    const bf16* Z = (const bf16*)(p.ws + WS_Z); const bf16* QR = (const bf16*)(p.ws + WS_B2); const bf16* KR = (const bf16*)(p.ws + WS_KR); bf16* O = (bf16*)(p.ws + WS_B3);
    const int lane = tidx & 63, gw = (blockIdx.x * blockDim.x + tidx) >> 6, nw = (gridDim.x * blockDim.x) >> 6;
    for (int unit = gw; unit < R * H_ATT; unit += nw) {
        const int r = unit >> 4, hh = unit & 15, kv = hh >> 2;
        const bool smp = r >= RPROMPT; const int t = smp ? 0 : (r & (SEQ - 1)), bb = r - RPROMPT;
        const float qv = bf2f(QR[(size_t)r * D + hh * HD + lane]);
        const float* ck = p.in[I_SWK] + (((size_t)l * DB + (smp ? bb : 0)) * WINDOW) * KV_ATT * HD;
        const float* cv = p.in[I_SWV] + (((size_t)l * DB + (smp ? bb : 0)) * WINDOW) * KV_ATT * HD;
        float s[2] = {0.f, 0.f};
#pragma unroll 1
        for (int half = 0; half < 2; ++half) {
            const int w = lane + 64 * half;
            float kk[64]; bool valid = true;
            if (!smp) { valid = (t - (WINDOW - 1) + w) >= 0;
                const bf16* kr = KR + (size_t)(valid ? r - (WINDOW - 1) + w : r) * 256 + kv * HD;
#pragma unroll
                for (int j = 0; j < 8; ++j) { float tmp[8]; ld8(kr + j * 8, tmp);
#pragma unroll
                    for (int i = 0; i < 8; ++i) kk[j * 8 + i] = tmp[i]; } }
            else if (w < WINDOW - 1) { const float* kr = ck + ((size_t)(w + 1) * KV_ATT + kv) * HD;
#pragma unroll
                for (int j = 0; j < 8; ++j) { float tmp[8]; ld8f(kr + j * 8, tmp);
#pragma unroll
                    for (int i = 0; i < 8; ++i) kk[j * 8 + i] = tmp[i]; } }
            else { const bf16* kr = KR + (size_t)r * 256 + kv * HD;
#pragma unroll
                for (int j = 0; j < 8; ++j) { float tmp[8]; ld8(kr + j * 8, tmp);
#pragma unroll
                    for (int i = 0; i < 8; ++i) kk[j * 8 + i] = tmp[i]; } }
            float acc = 0.f;
#pragma unroll
            for (int d = 0; d < 64; ++d) acc += __shfl(qv, d) * kk[d];
            const float sv = valid ? acc * 0.125f : -INFINITY; if (half == 0) s[0] = sv; else s[1] = sv;
        }
        const float sink = p.in[I_SINK][l * H_ATT + hh];
        const float m = fmaxf(wave_max(fmaxf(s[0], s[1])), sink);
        const float e0 = __expf(s[0] - m), e1 = __expf(s[1] - m);
        const float den = wave_sum(e0 + e1) + __expf(sink - m);
        const float p0 = e0 / den, p1 = e1 / den;
        float o = 0.f;
        for (int w = 0; w < WINDOW; ++w) {
            const float pw = w < 64 ? __shfl(p0, w) : __shfl(p1, w - 64);
            float vv;
            if (!smp) { const bool valid = (t - (WINDOW - 1) + w) >= 0; vv = valid ? bf2f(Z[(size_t)(r - (WINDOW - 1) + w) * IN_PAD + C_V + kv * HD + lane]) : 0.f; }
            else if (w < WINDOW - 1) vv = cv[((size_t)(w + 1) * KV_ATT + kv) * HD + lane];
            else vv = bf2f(Z[(size_t)r * IN_PAD + C_V + kv * HD + lane]);
            o += pw * vv;
        }
        O[(size_t)r * D + hh * HD + lane] = (bf16)f2bf(o);
    }
}

__device__ __forceinline__ void ph_resnorm(const Params& p, const float* gpost, const float* gnext) {
    const int tidx = tid_opaque();
    const float* OUTF = (const float*)(p.ws + WS_F1); bf16* XN = (bf16*)(p.ws + WS_XN);
    const int lane = tidx & 63, gw = (blockIdx.x * blockDim.x + tidx) >> 6, nw = (gridDim.x * blockDim.x) >> 6;
    for (int r = gw; r < R; r += nw) {
        f32x4 v[4], x[4]; float ss = 0.f;
#pragma unroll
        for (int j = 0; j < 4; ++j) { v[j] = *(const f32x4*)(OUTF + (size_t)r * D + lane * 4 + j * 256); ss += v[j].x * v[j].x + v[j].y * v[j].y + v[j].z * v[j].z + v[j].w * v[j].w; }
        const float rstd = rsqrtf(wave_sum(ss) * (1.f / D) + EPS);
        float s2 = 0.f;
#pragma unroll
        for (int j = 0; j < 4; ++j) { const f32x4 gg = *(const f32x4*)(gpost + lane * 4 + j * 256); float* xp = p.out + (size_t)r * D + lane * 4 + j * 256;
            x[j] = *(const f32x4*)xp + v[j] * rstd * gg; *(f32x4*)xp = x[j]; s2 += x[j].x * x[j].x + x[j].y * x[j].y + x[j].z * x[j].z + x[j].w * x[j].w; }
        if (gnext) {
            const float rstd2 = rsqrtf(wave_sum(s2) * (1.f / D) + EPS);
#pragma unroll
            for (int j = 0; j < 4; ++j) { const f32x4 gg = *(const f32x4*)(gnext + lane * 4 + j * 256);
                u32x2 w; w.x = pk2(x[j].x * rstd2 * gg.x, x[j].y * rstd2 * gg.y); w.y = pk2(x[j].z * rstd2 * gg.z, x[j].w * rstd2 * gg.w);
                *(u32x2*)(XN + (size_t)r * D + lane * 4 + j * 256) = w; }
        }
    }
}

__device__ __forceinline__ void ph_xattn(const Params& p, const int l) {
    const int tidx = tid_opaque();
    const bf16* Q2 = (const bf16*)(p.ws + WS_B1); const bf16* MK = (const bf16*)(p.ws + WS_MK); const bf16* MV = (const bf16*)(p.ws + WS_MV); bf16* O2 = (bf16*)(p.ws + WS_B2);
    const int lane = tidx & 63, gw = (blockIdx.x * blockDim.x + tidx) >> 6, nw = (gridDim.x * blockDim.x) >> 6;
    for (int unit = gw; unit < R * XH; unit += nw) {
        const int r = unit >> 2, hh = unit & 3; const bool smp = r >= RPROMPT; const int bb = smp ? r - RPROMPT : r >> 11;
        float q[4]; { const u32x2 w = *(const u32x2*)(Q2 + (size_t)r * D + hh * XHD + lane * 4); q[0] = bf2f(w.x & 0xffffu); q[1] = bf2f(w.x >> 16); q[2] = bf2f(w.y & 0xffffu); q[3] = bf2f(w.y >> 16); }
        const float* ck = p.in[I_CMK] + (((size_t)l * DB + (smp ? bb : 0)) * MEM) * XH * XHD + hh * XHD + lane * 4;
        const float* cv = p.in[I_CMV] + (((size_t)l * DB + (smp ? bb : 0)) * MEM) * XH * XHD + hh * XHD + lane * 4;
        const bf16* mk = MK + ((size_t)(smp ? 0 : bb) * MEM) * D + hh * XHD + lane * 4; const bf16* mv = MV + ((size_t)(smp ? 0 : bb) * MEM) * D + hh * XHD + lane * 4;
        float sc[4];
#pragma unroll
        for (int jo = 0; jo < 4; ++jo) { sc[jo] = 0.f;
            for (int ji = 0; ji < 64; ++ji) { const int key = jo * 64 + ji; float k4[4];
                if (smp) { const f32x4 kv = *(const f32x4*)(ck + (size_t)key * XH * XHD); k4[0] = kv.x; k4[1] = kv.y; k4[2] = kv.z; k4[3] = kv.w; }
                else { const u32x2 w = *(const u32x2*)(mk + (size_t)key * D); k4[0] = bf2f(w.x & 0xffffu); k4[1] = bf2f(w.x >> 16); k4[2] = bf2f(w.y & 0xffffu); k4[3] = bf2f(w.y >> 16); }
                const float s = wave_sum(q[0] * k4[0] + q[1] * k4[1] + q[2] * k4[2] + q[3] * k4[3]) * 0.0625f;
                if (ji == lane) sc[jo] = s; } }
        const float m = wave_max(fmaxf(fmaxf(sc[0], sc[1]), fmaxf(sc[2], sc[3])));
        float e[4]; float es = 0.f;
#pragma unroll
        for (int jo = 0; jo < 4; ++jo) { e[jo] = __expf(sc[jo] - m); es += e[jo]; }
        const float inv = 1.f / wave_sum(es);
        float o[4] = {0.f, 0.f, 0.f, 0.f};
#pragma unroll
        for (int jo = 0; jo < 4; ++jo)
            for (int ji = 0; ji < 64; ++ji) { const int key = jo * 64 + ji; const float pk = __shfl(e[jo], ji) * inv; float v4[4];
                if (smp) { const f32x4 vv = *(const f32x4*)(cv + (size_t)key * XH * XHD); v4[0] = vv.x; v4[1] = vv.y; v4[2] = vv.z; v4[3] = vv.w; }
                else { const u32x2 w = *(const u32x2*)(mv + (size_t)key * D); v4[0] = bf2f(w.x & 0xffffu); v4[1] = bf2f(w.x >> 16); v4[2] = bf2f(w.y & 0xffffu); v4[3] = bf2f(w.y >> 16); }
                o[0] += pk * v4[0]; o[1] += pk * v4[1]; o[2] += pk * v4[2]; o[3] += pk * v4[3]; }
        u32x2 w; w.x = pk2(o[0], o[1]); w.y = pk2(o[2], o[3]); *(u32x2*)(O2 + (size_t)r * D + hh * XHD + lane * 4) = w;
    }
}

__device__ __forceinline__ void ph_ffnconv(const Params& p, const int l) {
    const int tidx = tid_opaque();
    const bf16* AG = (const bf16*)(p.ws + WS_AG); bf16* HID = (bf16*)(p.ws + WS_HID);
    const float* cw = p.in[I_FCW] + (size_t)l * 3 * DFF; const float* cb = p.in[I_FCB] + (size_t)l * DFF;
    const int nitems = R * (DFF / 8);
    for (int it = blockIdx.x * blockDim.x + tidx; it < nitems; it += gridDim.x * blockDim.x) {
        const int r = it / (DFF / 8), c0 = (it % (DFF / 8)) * 8;
        float x[3][8], g[8], c[8], acc[8];
        const bf16* ar = AG + (size_t)r * 2 * DFF + c0;
        ld8(ar, x[2]); ld8(ar + DFF, g);
        if (r < RPROMPT) {
            const int t = r & (SEQ - 1);
#pragma unroll
            for (int k = 0; k < 2; ++k) {
                if (t - 2 + k >= 0) ld8(ar - (size_t)(2 - k) * 2 * DFF, x[k]);
                else {
#pragma unroll
                    for (int i = 0; i < 8; ++i) x[k][i] = 0.f; }
            }
            if (t >= SEQ - 2) st8f(p.out + O_PFC + (((size_t)l * BATCH + (r >> 11)) * 2 + (t - (SEQ - 2))) * DFF + c0, x[2]);
        } else {
            const int bb = r - RPROMPT; const float* buf = p.in[I_SFC] + ((size_t)l * DB + bb) * 2 * DFF;
            ld8f(buf + c0, x[0]); ld8f(buf + DFF + c0, x[1]);
            float* so = p.out + O_SFC + ((size_t)l * DB + bb) * 2 * DFF;
            st8f(so + c0, x[1]); st8f(so + DFF + c0, x[2]);
        }
        ld8f(cb + c0, acc);
#pragma unroll
        for (int k = 0; k < 3; ++k) { ld8f(cw + (size_t)k * DFF + c0, c);
#pragma unroll
            for (int i = 0; i < 8; ++i) acc[i] += c[i] * x[k][i]; }
#pragma unroll
        for (int i = 0; i < 8; ++i) acc[i] = siluf_(acc[i]) * g[i];
        st8(HID + (size_t)r * DFF + c0, acc);
    }
}


namespace pg8 {
#define PG8_LAS __attribute__((address_space(3)))
typedef unsigned short bf16_t;
typedef short bf16x8 __attribute__((ext_vector_type(8)));
typedef float f32x4 __attribute__((ext_vector_type(4)));
typedef unsigned u32x4 __attribute__((ext_vector_type(4)));
constexpr int BM = 256, BK = 64, HALF = 128, HTB = HALF * BK * 2  , STAGE_BYTES = 8 * HTB, NXCD = 8, WGM = 8;

__host__ __device__ __forceinline__ int lds_byte(int r, int c) { const int st = (r >> 4) * 2 + (c >> 5), rr = r & 15, cc = c & 31, ob = rr * 64 + cc * 2; return st * 1024 + (ob ^ (((ob >> 9) & 1) << 5)); }
__host__ __device__ __forceinline__ void stage_rc(int b, int& R, int& C) { const int st = b / 1024, sb = b % 1024, swz = sb ^ (((sb >> 9) & 1) << 5); R = (st >> 1) * 16 + swz / 64; C = (st & 1) * 32 + (swz % 64) / 2; }
__host__ __device__ __forceinline__ int perm32(int rho) { const int n = rho >> 4, i = rho & 15; return 8 * (i >> 2) + 4 * n + (i & 3); }

struct Unit { int pm, pn; };
struct Gemm { const bf16_t* A; const bf16_t* Bt; int M, N, K; };

struct StaticOrder {
    int nM, nN, nwg, G, c;
    __host__ __device__ void init(int M, int N, int G_, int c_) { nM = M / BM; nN = N / BM; nwg = nM * nN; G = G_; c = c_; }
    __host__ __device__ bool next(int i, Unit& u) const {
        const long L = (long)i * G + c; if (L >= nwg) return false;
        int wgid = (int)L; { const int q = nwg / NXCD, r = nwg % NXCD, xcd = wgid % NXCD, off = wgid / NXCD; wgid = (xcd < r ? xcd * (q + 1) : r * (q + 1) + (xcd - r) * q) + off; }
        const int nig = WGM * nN, gid = wgid / nig, fm = gid * WGM, gsz = (nM - fm) < WGM ? (nM - fm) : WGM;
        u.pm = fm + ((wgid % nig) % gsz); u.pn = (wgid % nig) / gsz; return true;
    }
    __device__ __forceinline__ void a_ready(const Unit&) const {}
    __device__ __forceinline__ void done(const Unit&) const {}
};

__device__ __forceinline__ unsigned cvt_pk_bf16(float lo, float hi) { unsigned r; asm volatile("v_cvt_pk_bf16_f32 %0, %1, %2" : "=v"(r) : "v"(lo), "v"(hi)); return r; }
template <class F> struct EpiAdapt {
    static constexpr bool PERM = false, AFTER_DRAIN = false; F f;
    __device__ __forceinline__ void operator()(const f32x4 (&acc)[2][2][4][2], const Unit& u, int wr, int wc, int fr, int fq) const {
#pragma unroll
        for (int ai = 0; ai < 2; ++ai)
#pragma unroll
            for (int m = 0; m < 4; ++m) { const int row = u.pm * BM + ai * HALF + wr * 64 + m * 16 + fr;
#pragma unroll
                for (int bj = 0; bj < 2; ++bj)
#pragma unroll
                    for (int n = 0; n < 2; ++n) f(row, u.pn * BM + bj * HALF + wc * 32 + n * 16 + fq * 4, acc[ai][bj][m][n]); }
    }
};
template <class Epi, class Sched, bool ALIGN_EPI = false, bool SP2 = false>
__device__ __forceinline__ void gemm_phase(PG8_LAS unsigned char* lds, const Gemm g, const Sched& S, const Epi& E) {
    int tid_ = threadIdx.x; asm volatile("" : "+v"(tid_));
    const int tid = tid_, wid = __builtin_amdgcn_readfirstlane(tid >> 6), lane = tid & 63, wr = wid >> 2, wc = wid & 3, fr = lane & 15, fq = lane >> 4;
    const int K = g.K, nt = K / BK;
    unsigned voffA[2], voffB[2];
#pragma unroll
    for (int i = 0; i < 2; ++i) { int R, C; stage_rc(tid * 16 + i * 8192, R, C); const int Rb = Epi::PERM ? ((R & ~31) + perm32(R & 31)) : R;
        voffA[i] = (unsigned)(R * K + C) * 2u; voffB[i] = (unsigned)(Rb * K + C) * 2u; }
    const size_t kstep = (size_t)(BK * 2);
    const size_t hstep = (size_t)HALF * K * 2;
    const size_t tstep = 2 * hstep;
    const unsigned ldsw = (unsigned)wid * 1024u;
    const int aoff = lds_byte(wr * 64 + fr, fq * 8), boff = lds_byte(wc * 32 + fr, fq * 8);
#define PG8_SA(b, h) (((b) * 2 + (h)) * HTB)
#define PG8_SB(b, h) ((4 + (b) * 2 + (h)) * HTB)
#define PG8_STAGE(bufoff, gbase, voff) do { _Pragma("unroll") for (int _i = 0; _i < 2; ++_i) \
        __builtin_amdgcn_global_load_lds((const unsigned*)((const char*)(gbase) + (voff)[_i]), (PG8_LAS unsigned*)(lds + (bufoff) + ldsw + _i * 8192), 16, 0, 0); } while (0)
#define PG8_LDA(dst, b, h) do { _Pragma("unroll") for (int m = 0; m < 4; ++m) _Pragma("unroll") for (int k = 0; k < 2; ++k) dst[m][k] = *(const PG8_LAS bf16x8*)(lds + PG8_SA(b, h) + aoff + m * 2048 + k * 1024); } while (0)
#define PG8_LDB(dst, b, h) do { _Pragma("unroll") for (int n = 0; n < 2; ++n) _Pragma("unroll") for (int k = 0; k < 2; ++k) dst[n][k] = *(const PG8_LAS bf16x8*)(lds + PG8_SB(b, h) + boff + n * 2048 + k * 1024); } while (0)
#define PG8_MMA(ai, bj, At, Bt) do { __builtin_amdgcn_s_setprio(1); _Pragma("unroll") for (int m = 0; m < 4; ++m) _Pragma("unroll") for (int n = 0; n < 2; ++n) _Pragma("unroll") for (int k = 0; k < 2; ++k) \
        acc[ai][bj][m][n] = __builtin_amdgcn_mfma_f32_16x16x32_bf16(Bt[n][k], At[m][k], acc[ai][bj][m][n], 0, 0, 0); __builtin_amdgcn_s_setprio(0); } while (0)
#define PG8_WAIT_V(n) asm volatile("s_waitcnt vmcnt(" #n ")" ::: "memory")
#define PG8_WAIT_L(n) asm volatile("s_waitcnt lgkmcnt(" #n ")" ::: "memory")
#define PG8_BAR __builtin_amdgcn_s_barrier()
#define PG8_SCHED __builtin_amdgcn_sched_barrier(0)
    Unit cur, nxt; int ui = 0;
    if (!S.next(0, cur)) return;
    f32x4 acc[2][2][4][2];
#pragma unroll
    for (int a = 0; a < 2; ++a)
#pragma unroll
        for (int b = 0; b < 2; ++b)
#pragma unroll
            for (int m = 0; m < 4; ++m)
#pragma unroll
                for (int n = 0; n < 2; ++n) acc[a][b][m][n] = (f32x4){0.f, 0.f, 0.f, 0.f};
    bf16x8 At[4][2], B0[2][2], B1[2][2];
    const char* cA = (const char*)g.A + (size_t)cur.pm * tstep; const char* cB = (const char*)g.Bt + (size_t)cur.pn * tstep;
    S.a_ready(cur);
    if constexpr (SP2) {
        PG8_STAGE(PG8_SB(0, 0), cB, voffB); PG8_STAGE(PG8_SB(0, 1), cB + hstep, voffB); PG8_STAGE(PG8_SA(0, 0), cA, voffA); PG8_STAGE(PG8_SA(0, 1), cA + hstep, voffA);
        if (wr == 1) PG8_BAR;
        PG8_WAIT_V(2); PG8_BAR;
        PG8_STAGE(PG8_SB(1, 0), cB + kstep, voffB); PG8_STAGE(PG8_SA(1, 0), cA + kstep, voffA); PG8_STAGE(PG8_SB(1, 1), cB + hstep + kstep, voffB);
        PG8_WAIT_V(6); PG8_BAR;
    } else {
        PG8_STAGE(PG8_SB(0, 0), cB, voffB); PG8_STAGE(PG8_SA(0, 0), cA, voffA); PG8_STAGE(PG8_SB(0, 1), cB + hstep, voffB); PG8_STAGE(PG8_SA(0, 1), cA + hstep, voffA);
        if (wr == 1) PG8_BAR;
        PG8_WAIT_V(4); PG8_BAR;
        PG8_STAGE(PG8_SB(1, 0), cB + kstep, voffB); PG8_STAGE(PG8_SA(1, 0), cA + kstep, voffA); PG8_STAGE(PG8_SB(1, 1), cB + hstep + kstep, voffB);
        PG8_WAIT_V(6); PG8_BAR;
    }
    for (;;) {
        const bool has_next = S.next(ui + 1, nxt);
        const char* nA = has_next ? (const char*)g.A + (size_t)nxt.pm * tstep : cA; const char* nB = has_next ? (const char*)g.Bt + (size_t)nxt.pn * tstep : cB;
        for (int t = 0; t < nt; t += 2) {
            const bool last = (t == nt - 2);
            const char* a1 = cA + (size_t)(t + 1) * kstep;
            const char* a2 = last ? nA : cA + (size_t)(t + 2) * kstep; const char* b2 = last ? nB : cB + (size_t)(t + 2) * kstep;
            const char* a3 = a2 + kstep; const char* b3 = b2 + kstep;
            if (last && has_next) S.a_ready(nxt);
            if constexpr (SP2) {
            PG8_LDB(B0, 0, 0); PG8_LDB(B1, 0, 1); PG8_SCHED; PG8_LDA(At, 0, 0); PG8_STAGE(PG8_SA(1, 1), a1 + hstep, voffA);
            PG8_WAIT_V(8); PG8_WAIT_L(0); PG8_BAR; PG8_MMA(0, 0, At, B0); PG8_MMA(0, 1, At, B1); PG8_BAR; PG8_SCHED;
            PG8_LDA(At, 0, 1); PG8_STAGE(PG8_SB(0, 0), b2, voffB); PG8_STAGE(PG8_SB(0, 1), b2 + hstep, voffB); PG8_STAGE(PG8_SA(0, 0), a2, voffA);
            PG8_WAIT_V(8); PG8_WAIT_L(0); PG8_BAR; PG8_MMA(1, 0, At, B0); PG8_MMA(1, 1, At, B1); PG8_BAR; PG8_SCHED;
            PG8_LDB(B0, 1, 0); PG8_LDB(B1, 1, 1); PG8_SCHED; PG8_LDA(At, 1, 0); PG8_STAGE(PG8_SA(0, 1), a2 + hstep, voffA);
            PG8_WAIT_V(8); PG8_WAIT_L(0); PG8_BAR; PG8_MMA(0, 0, At, B0); PG8_MMA(0, 1, At, B1); PG8_BAR; PG8_SCHED;
            PG8_LDA(At, 1, 1); PG8_STAGE(PG8_SB(1, 0), b3, voffB); PG8_STAGE(PG8_SB(1, 1), b3 + hstep, voffB); PG8_STAGE(PG8_SA(1, 0), a3, voffA);
            PG8_WAIT_V(8); PG8_WAIT_L(0); PG8_BAR; PG8_MMA(1, 0, At, B0); PG8_MMA(1, 1, At, B1); PG8_BAR; PG8_SCHED;
            } else {
            PG8_LDB(B0, 0, 0); PG8_SCHED; PG8_LDA(At, 0, 0); PG8_STAGE(PG8_SA(1, 1), a1 + hstep, voffA);
            PG8_WAIT_L(8); PG8_BAR; PG8_WAIT_L(0); PG8_MMA(0, 0, At, B0); PG8_BAR; PG8_SCHED;
            PG8_LDB(B1, 0, 1); PG8_STAGE(PG8_SB(0, 0), b2, voffB);
            PG8_BAR; PG8_WAIT_L(0); PG8_MMA(0, 1, At, B1); PG8_BAR;
            PG8_LDA(At, 0, 1); PG8_STAGE(PG8_SA(0, 0), a2, voffA);
            PG8_BAR; PG8_WAIT_L(0); PG8_MMA(1, 0, At, B0); PG8_BAR; PG8_SCHED;
            PG8_STAGE(PG8_SB(0, 1), b2 + hstep, voffB);
            PG8_WAIT_V(6); PG8_BAR; PG8_MMA(1, 1, At, B1); PG8_BAR;
            PG8_LDB(B0, 1, 0); PG8_SCHED; PG8_LDA(At, 1, 0); PG8_STAGE(PG8_SA(0, 1), a2 + hstep, voffA);
            PG8_WAIT_L(8); PG8_BAR; PG8_WAIT_L(0); PG8_MMA(0, 0, At, B0); PG8_BAR; PG8_SCHED;
            PG8_LDB(B1, 1, 1); PG8_STAGE(PG8_SB(1, 0), b3, voffB);
            PG8_BAR; PG8_WAIT_L(0); PG8_MMA(0, 1, At, B1); PG8_BAR;
            PG8_LDA(At, 1, 1); PG8_STAGE(PG8_SA(1, 0), a3, voffA);
            PG8_BAR; PG8_WAIT_L(0); PG8_MMA(1, 0, At, B0); PG8_BAR; PG8_SCHED;
            PG8_STAGE(PG8_SB(1, 1), b3 + hstep, voffB);
            PG8_WAIT_V(6); PG8_BAR; PG8_MMA(1, 1, At, B1); PG8_BAR;
            }
        }
        if constexpr (ALIGN_EPI) { if (wr == 0) PG8_BAR; }
        if constexpr (!Epi::AFTER_DRAIN) { E(acc, cur, wr, wc, fr, fq); S.done(cur); }
        if (!has_next) break;
#pragma unroll
        for (int a = 0; a < 2; ++a)
#pragma unroll
            for (int b = 0; b < 2; ++b)
#pragma unroll
                for (int m = 0; m < 4; ++m)
#pragma unroll
                    for (int n = 0; n < 2; ++n) acc[a][b][m][n] = (f32x4){0.f, 0.f, 0.f, 0.f};
        cur = nxt; cA = nA; cB = nB; ++ui;
        if constexpr (ALIGN_EPI) { if (wr == 1) PG8_BAR; }
    }
    PG8_WAIT_V(0);
    if constexpr (!ALIGN_EPI) { if (wr == 0) PG8_BAR; }
    PG8_BAR;
    if constexpr (Epi::AFTER_DRAIN) { E.fused(acc, cur, wr, wc, fr, fq, lds, wid, lane); S.done(cur); }
#undef PG8_SA
#undef PG8_SB
#undef PG8_STAGE
#undef PG8_LDA
#undef PG8_LDB
#undef PG8_MMA
#undef PG8_WAIT_V
#undef PG8_WAIT_L
#undef PG8_BAR
#undef PG8_SCHED
}
}

#define GAS __attribute__((address_space(1)))
#define LAS __attribute__((address_space(3)))
typedef GAS unsigned gu32;
#define RLX_AGENT __ATOMIC_RELAXED, __HIP_MEMORY_SCOPE_AGENT
#define LDS_WAIT() asm volatile("s_waitcnt lgkmcnt(0)" ::: "memory")
constexpr int NT = 512, NWAVES = 8;
constexpr int RING_OFF = 0, RING_BYTES = 131072;
constexpr int LDSCTL_OFF = RING_BYTES, MISC_OFF = LDSCTL_OFF + 320;
constexpr int LDS_BYTES = 147456;
constexpr int CW_BAR = 4096;
constexpr size_t CTL_ZERO_BYTES = 1 * MiB;
#define XB_TMO      128
#define XB_XCNT(j)  (256  + 64 * (j))
#define XB_XSUB(j)  (1280 + 64 * (j))
#define XB_XGEN(j)  (2304 + 64 * (j))
#define XB_TOP      3328
#define XB_TOPGEN   3392
#define XCD_BAR_WORDS 3456
#define XB_SPIN_CAP (1u << 18)

__device__ __forceinline__ unsigned xb_ld(unsigned* p)              { return __hip_atomic_load(p, __ATOMIC_RELAXED, __HIP_MEMORY_SCOPE_AGENT); }
__device__ __forceinline__ unsigned xb_add(unsigned* p, unsigned v) { return __hip_atomic_fetch_add(p, v, __ATOMIC_RELAXED, __HIP_MEMORY_SCOPE_AGENT); }
__device__ __forceinline__ unsigned xb_xcc_id() { return (unsigned)__builtin_amdgcn_s_getreg((3 << 11) | 20) & 0xFu; }
#define XB_SPIN(cond, bar) do { unsigned _sp = 0; while (cond) { __builtin_amdgcn_s_sleep(1); \
    if ((++_sp & 255u) == 0u) { if (xb_ld(&(bar)[XB_TMO])) break; if (_sp > XB_SPIN_CAP) { atomicAdd(&(bar)[XB_TMO], 1u); break; } } } } while (0)

struct XcdBarrier {
    unsigned* bar; unsigned x;
    volatile LAS unsigned* st;
};

__device__ __forceinline__ XcdBarrier xcd_barrier_post(unsigned* bar, volatile LAS unsigned* st) {
    XcdBarrier b; b.bar = bar; b.x = xb_xcc_id(); b.st = st;
    if (threadIdx.x == 0) (void)xb_add(&bar[XB_XCNT(b.x)], 1u);
    return b;
}
__device__ __forceinline__ void xcd_barrier_complete(unsigned* bar, unsigned x, unsigned& nloc, unsigned& nx) {
    const unsigned G = gridDim.x * gridDim.y * gridDim.z;
    unsigned sum, cnt, mine, sp = 0u;
    for (;;) {
        sum = 0u; cnt = 0u; mine = 0u;
#pragma unroll
        for (unsigned j = 0; j < 16; ++j) { const unsigned c = xb_ld(&bar[XB_XCNT(j)]); sum += c; cnt += (c > 0u) ? 1u : 0u; mine = (j == x) ? c : mine; }
        if (sum == G) break;
        __builtin_amdgcn_s_sleep(1);
        if ((++sp & 255u) == 0u) { if (xb_ld(&bar[XB_TMO])) break; if (sp > XB_SPIN_CAP) { atomicAdd(&bar[XB_TMO], 1u); break; } }
    }
    nloc = mine > 0u ? mine : 1u; nx = cnt > 0u ? cnt : 1u;
}

__device__ __forceinline__ void xcd_barrier(const XcdBarrier& b) {
    asm volatile("s_waitcnt vmcnt(0)" ::: "memory");
    __syncthreads();
    if (threadIdx.x == 0) {
        unsigned* bar = b.bar;
        __builtin_amdgcn_s_waitcnt(0);
        unsigned nloc = b.st[0], nx = b.st[1];
        if (nloc == 0u) { xcd_barrier_complete(bar, b.x, nloc, nx); b.st[0] = nloc; b.st[1] = nx; }
        const unsigned old = xb_add(&bar[XB_XSUB(b.x)], 1u);
        const unsigned gen = old / nloc;
        if (old + 1u == (gen + 1u) * nloc) {
            __builtin_amdgcn_fence(__ATOMIC_RELEASE, "agent");
            asm volatile("s_waitcnt vmcnt(0)" ::: "memory");
            const unsigned og = xb_add(&bar[XB_TOP], 1u);
            const unsigned tg = og / nx;
            if (og + 1u == (tg + 1u) * nx) xb_add(&bar[XB_TOPGEN], 1u);
            else XB_SPIN(xb_ld(&bar[XB_TOPGEN]) == tg, bar);
            __builtin_amdgcn_fence(__ATOMIC_ACQUIRE, "agent");
            xb_add(&bar[XB_XGEN(b.x)], 1u);
            asm volatile("s_waitcnt vmcnt(0)" ::: "memory");
        } else {
            XB_SPIN(xb_ld(&bar[XB_XGEN(b.x)]) == gen, bar);
            __builtin_amdgcn_fence(__ATOMIC_ACQUIRE, "agent");
            asm volatile("s_waitcnt vmcnt(0)" ::: "memory");
        }
    }
    __syncthreads();
}

__device__ __forceinline__ void p0_transpose_item(const float* W, int K, int N, bf16* WT, int row_off, LAS float* scr, int item, int lane) {
    const int nblk = N / 32, kb = item / nblk, nb = item % nblk, k0 = 64 * kb, n0 = 32 * nb;
#pragma unroll 8
    for (int i = 0; i < 32; ++i) { const int kk = 2 * i + (lane >> 5); scr[kk * 33 + (lane & 31)] = W[(size_t)(k0 + kk) * N + n0 + (lane & 31)]; }
    LDS_WAIT(); asm volatile("" ::: "memory");
    const int c = lane & 7;
#pragma unroll
    for (int j = 0; j < 4; ++j) { const int n = (lane >> 3) + 8 * j; const LAS float* s = scr + (8 * c) * 33 + n;
        u32x4 o; o.x = pk2(s[0 * 33], s[1 * 33]); o.y = pk2(s[2 * 33], s[3 * 33]); o.z = pk2(s[4 * 33], s[5 * 33]); o.w = pk2(s[6 * 33], s[7 * 33]);
        *(u32x4*)(WT + (size_t)(row_off + n0 + n) * K + k0 + 8 * c) = o; }
    LDS_WAIT(); asm volatile("" ::: "memory");
}
__device__ __forceinline__ void wconv_mat(const float* W, int K, int N, bf16* WT, int row_off, LAS float* scr, int gw, int ngw, int lane) {
    const int nitems = (K / 64) * (N / 32);
    for (int item = gw; item < nitems; item += ngw) p0_transpose_item(W, K, N, WT, row_off, scr, item, lane);
}
__device__ __forceinline__ void ph_prologue(const Params& p, LAS unsigned char* lds) {
    const int tid = threadIdx.x, lane = tid & 63, wave = tid >> 6;
    LAS float* scr = (LAS float*)(lds + RING_OFF + wave * 16384);
    const int gw = blockIdx.x * NWAVES + wave, ngw = gridDim.x * NWAVES;
    for (int l = 0; l < DEPTH; ++l) {
        unsigned char* wl = p.ws + WS_W + l * W_LAYER;
        wconv_mat(p.in[I_WIN] + (size_t)l * D * IN_DIM, D, IN_DIM, (bf16*)(wl + W_IN), 0, scr, gw, ngw, lane);
        wconv_mat(p.in[I_WAO] + (size_t)l * D * D, D, D, (bf16*)(wl + W_A), 0, scr, gw, ngw, lane);
        wconv_mat(p.in[I_WSO] + (size_t)l * DSSM * D, DSSM, D, (bf16*)(wl + W_SSM), 0, scr, gw, ngw, lane);
        wconv_mat(p.in[I_WATT] + (size_t)l * D * D, D, D, (bf16*)(wl + W_ATT), 0, scr, gw, ngw, lane);
        wconv_mat(p.in[I_WOUT] + (size_t)l * D * D, D, D, (bf16*)(wl + W_OUT), 0, scr, gw, ngw, lane);
        wconv_mat(p.in[I_WXQ] + (size_t)l * D * D, D, D, (bf16*)(wl + W_XQ), 0, scr, gw, ngw, lane);
        wconv_mat(p.in[I_WXK] + (size_t)l * D * D, D, D, (bf16*)(wl + W_XKV), 0, scr, gw, ngw, lane);
        wconv_mat(p.in[I_WXV] + (size_t)l * D * D, D, D, (bf16*)(wl + W_XKV), D, scr, gw, ngw, lane);
        wconv_mat(p.in[I_WXO] + (size_t)l * D * D, D, D, (bf16*)(wl + W_XO), 0, scr, gw, ngw, lane);
        wconv_mat(p.in[I_WFI] + (size_t)l * D * 2 * DFF, D, 2 * DFF, (bf16*)(wl + W_FFI), 0, scr, gw, ngw, lane);
        wconv_mat(p.in[I_WFO] + (size_t)l * DFF * D, DFF, D, (bf16*)(wl + W_FFO), 0, scr, gw, ngw, lane);
        u32x4* pad = (u32x4*)(wl + W_IN + (size_t)IN_DIM * D * 2); const int npad = (IN_PAD - IN_DIM) * D * 2 / 16;
        for (int i = blockIdx.x * NT + tid; i < npad; i += gridDim.x * NT) pad[i] = (u32x4){0u, 0u, 0u, 0u};
    }
    { u32x4* pad = (u32x4*)(p.ws + WS_XN + (size_t)R * D * 2); const int npad = (RPAD - R) * D * 2 / 16;
      for (int i = blockIdx.x * NT + tid; i < npad; i += gridDim.x * NT) pad[i] = (u32x4){0u, 0u, 0u, 0u}; }
    ph_xinit(p);
    ph_normrows(p.in[I_MEM], BATCH * MEM, p.in[I_NMEM], (bf16*)(p.ws + WS_MN));
}

#ifndef MK_PER_PHASE
#define MK_PER_PHASE 0
#endif
constexpr int NPH = 15, N_PHASES = 1 + DEPTH * NPH;
struct Args { Params p; long ph_lo, ph_hi; };

template <class F> __device__ __forceinline__ void run_gemm(LAS unsigned char* lds, const bf16* A, const bf16* Bt, int M, int N, int K, const F& f) {
    pg8::Gemm g{A, Bt, M, N, K}; pg8::StaticOrder S; S.init(M, N, (int)gridDim.x, (int)blockIdx.x);
    pg8::EpiAdapt<F> E{f};
    pg8::gemm_phase<pg8::EpiAdapt<F>, pg8::StaticOrder, true, true>(lds + RING_OFF, g, S, E);
}

__global__ void __launch_bounds__(NT, 2) mega_fwd(Args args) {
    extern __shared__ __attribute__((aligned(16))) unsigned char lds_raw[];
    LAS unsigned char* lds = (LAS unsigned char*)lds_raw;
    volatile LAS unsigned* MISC = (volatile LAS unsigned*)(lds + MISC_OFF);
    const Params& p = args.p;
    for (int u = threadIdx.x; u < (LDS_BYTES - LDSCTL_OFF) / 4; u += NT) ((LAS unsigned*)(lds + LDSCTL_OFF))[u] = 0u;
    __syncthreads();
    unsigned* ctl = (unsigned*)(p.ws + WS_CTL);
    XcdBarrier bar; bar.bar = ctl + CW_BAR; bar.x = 0; bar.st = nullptr;
    if (!MK_PER_PHASE) bar = xcd_barrier_post(ctl + CW_BAR, MISC + 8);
    const int lo = (int)args.ph_lo, hi = (int)args.ph_hi;
#define IN(k) (lo <= (k) && (k) < hi)
#define SEAM(k) do { if (!MK_PER_PHASE && IN(k) && IN((k) + 1)) xcd_barrier(bar); } while (0)
    unsigned char* ws = p.ws;
    bf16 *Z = (bf16*)(ws + WS_Z), *YG = (bf16*)(ws + WS_YG), *XN = (bf16*)(ws + WS_XN), *B1 = (bf16*)(ws + WS_B1), *B2 = (bf16*)(ws + WS_B2), *B3 = (bf16*)(ws + WS_B3), *B4 = (bf16*)(ws + WS_B4);
    bf16 *AG = (bf16*)(ws + WS_AG), *HID = (bf16*)(ws + WS_HID), *MN = (bf16*)(ws + WS_MN), *MK = (bf16*)(ws + WS_MK), *MV = (bf16*)(ws + WS_MV);
    float *F0 = (float*)(ws + WS_F0), *F1 = (float*)(ws + WS_F1);

    if (IN(0)) ph_prologue(p, lds);
    SEAM(0);
    for (int l = 0; l < DEPTH; ++l) {
        const int b = 1 + l * NPH;
        const unsigned char* wl = ws + WS_W + (size_t)l * W_LAYER;
        if (IN(b + 0)) {
            run_gemm(lds, XN, (const bf16*)(wl + W_IN), RPAD, IN_PAD, D, EpiStoreBf16{Z, IN_PAD});
            run_gemm(lds, MN, (const bf16*)(wl + W_XKV), BATCH * MEM, 2 * D, D, EpiMemKV{p.out + O_PMK + (size_t)l * BATCH * MEM * D, p.out + O_PMV + (size_t)l * BATCH * MEM * D, MK, MV});
        }
        SEAM(b + 0);
        if (IN(b + 1)) { ph_mixa(p, l); ph_ssmconv(p, l); ph_dt(p, l); ph_rope(p, l); ph_swashift(p, l); }
        SEAM(b + 1);
        if (IN(b + 2)) { ph_ssd(p, l); ph_swa(p, l); }
        SEAM(b + 2);
        if (IN(b + 3)) ph_normyg(p, l);
        SEAM(b + 3);
        if (IN(b + 4)) {
            run_gemm(lds, B1, (const bf16*)(wl + W_A), RPAD, D, D, EpiGate<0>{Z, F0, B4});
            run_gemm(lds, YG, (const bf16*)(wl + W_SSM), RPAD, D, DSSM, EpiGate<1>{Z, F0, B4});
            run_gemm(lds, B3, (const bf16*)(wl + W_ATT), RPAD, D, D, EpiGate<2>{Z, F0, B4});
        }
        SEAM(b + 4);
        if (IN(b + 5)) run_gemm(lds, B4, (const bf16*)(wl + W_OUT), RPAD, D, D, EpiStoreF32{F1, D});
        SEAM(b + 5);
        if (IN(b + 6)) ph_resnorm(p, p.in[I_NMPOST] + (size_t)l * D, p.in[I_NXPRE] + (size_t)l * D);
        SEAM(b + 6);
        if (IN(b + 7)) run_gemm(lds, XN, (const bf16*)(wl + W_XQ), RPAD, D, D, EpiStoreBf16{B1, D});
        SEAM(b + 7);
        if (IN(b + 8)) ph_xattn(p, l);
        SEAM(b + 8);
        if (IN(b + 9)) run_gemm(lds, B2, (const bf16*)(wl + W_XO), RPAD, D, D, EpiStoreF32{F1, D});
        SEAM(b + 9);
        if (IN(b + 10)) ph_resnorm(p, p.in[I_NXPOST] + (size_t)l * D, p.in[I_NFPRE] + (size_t)l * D);
        SEAM(b + 10);
        if (IN(b + 11)) run_gemm(lds, XN, (const bf16*)(wl + W_FFI), RPAD, 2 * DFF, D, EpiStoreBf16{AG, 2 * DFF});
        SEAM(b + 11);
        if (IN(b + 12)) ph_ffnconv(p, l);
        SEAM(b + 12);
        if (IN(b + 13)) run_gemm(lds, HID, (const bf16*)(wl + W_FFO), RPAD, D, DFF, EpiStoreF32{F1, D});
        SEAM(b + 13);
        if (IN(b + 14)) {
            ph_resnorm(p, p.in[I_NFPOST] + (size_t)l * D, l + 1 < DEPTH ? p.in[I_NMPRE] + (size_t)(l + 1) * D : nullptr);
            if (l + 1 < DEPTH) ph_normrows(p.in[I_MEM], BATCH * MEM, p.in[I_NMEM] + (size_t)(l + 1) * D, MN);
        }
        SEAM(b + 14);
    }
#undef IN
#undef SEAM
}

extern "C" void kernel_launch(void* const* d_in, const int* in_sizes, int n_in, void* d_out, int out_size, void* d_ws, size_t ws_size, hipStream_t stream) {
    static int grid = 0;
    if (grid == 0) {
        if (n_in != N_IN || (size_t)out_size != O_END || ws_size < WS_END) { fprintf(stderr, "kernel_launch: unexpected shapes (n_in %d out %d ws %zu)\n", n_in, out_size, ws_size); grid = -1; return; }
        int dev = 0, cus = 0, per_cu = 0;
        if (hipGetDevice(&dev) != hipSuccess || hipDeviceGetAttribute(&cus, hipDeviceAttributeMultiprocessorCount, dev) != hipSuccess) { grid = -1; return; }
        if (hipFuncSetAttribute((const void*)mega_fwd, hipFuncAttributeMaxDynamicSharedMemorySize, LDS_BYTES) != hipSuccess) { fprintf(stderr, "kernel_launch: hipFuncSetAttribute failed\n"); grid = -1; return; }
        if (hipOccupancyMaxActiveBlocksPerMultiprocessor(&per_cu, (const void*)mega_fwd, NT, LDS_BYTES) != hipSuccess || per_cu < 1) fprintf(stderr, "kernel_launch: occupancy query says %d\n", per_cu);
        (void)hipGetLastError();
        grid = cus;
    }
    if (grid < 0) return;
    if (hipMemsetAsync((char*)d_ws + WS_CTL, 0, CTL_ZERO_BYTES, stream) != hipSuccess) return;
    Args a{};
    for (int i = 0; i < N_IN; ++i) a.p.in[i] = (const float*)d_in[i];
    a.p.out = (float*)d_out; a.p.ws = (unsigned char*)d_ws;
#if MK_PER_PHASE
    for (int ph = 0; ph < N_PHASES; ++ph) { a.ph_lo = ph; a.ph_hi = ph + 1; hipLaunchKernelGGL(mega_fwd, dim3(grid), dim3(NT), LDS_BYTES, stream, a); }
#else
    a.ph_lo = 0; a.ph_hi = N_PHASES;
    hipLaunchKernelGGL(mega_fwd, dim3(grid), dim3(NT), LDS_BYTES, stream, a);
#endif
}
```

```cpp
#include <hip/hip_runtime.h>
#include <cstdio>
#include <cstdint>

typedef unsigned short bf16;
typedef float f32x4 __attribute__((ext_vector_type(4)));
typedef unsigned u32x4 __attribute__((ext_vector_type(4)));
typedef unsigned u32x2 __attribute__((ext_vector_type(2)));

constexpr int D = 1024, BATCH = 8, SEQ = 2048, DEPTH = 2, DB = 128;
constexpr int RPROMPT = BATCH * SEQ;
constexpr int R = RPROMPT + DB;
constexpr int RPAD = 16640;
constexpr int DSSM = 2048, H_SSM = 32, P_SSM = 64, G_SSM = 8, N_SSM = 128, CD = 4096;
constexpr int H_ATT = 16, KV_ATT = 4, HD = 64, WINDOW = 128;
constexpr int MEM = 256, XH = 4, XHD = 256;
constexpr int DFF = 2816;
constexpr int IN_DIM = 13856, IN_PAD = 14080;
constexpr int PAST_LEN = 8192;
constexpr float EPS = 1e-6f;
constexpr int C_VA = 0, C_GB = 1024, C_GC = 2048, C_ZS = 3072, C_XBC = 5120, C_DT = 9216, C_Q = 9248, C_K = 10272, C_V = 10528, C_G = 10784;
static_assert(C_G + 3 * D == IN_DIM, "in-proj partition");

enum { I_XP = 0, I_XS, I_MEM, I_SCA, I_SSC, I_SSM, I_SWK, I_SWV, I_CMK, I_CMV, I_SFC, I_NMPRE, I_NMPOST, I_WIN, I_CAW, I_WAO, I_SCW, I_SCB, I_DTB, I_ALOG, I_SSD,
       I_SSN, I_WSO, I_SINK, I_WATT, I_WOUT, I_NXPRE, I_NXPOST, I_NMEM, I_WXQ, I_WXK, I_WXV, I_WXO, I_NFPRE, I_NFPOST, I_WFI, I_FCW, I_FCB, I_WFO, N_IN };
static_assert(N_IN == 39, "39 inputs");

constexpr size_t O_YP = 0, O_YS = 16777216, O_PCA = 16908288, O_PSC = 16941056, O_PSSM = 17137664, O_PSWK = 21331968, O_PSWV = 21856256, O_PFC = 22380544,
                 O_PMK = 22470656, O_PMV = 26664960, O_SCA = 30859264, O_SSC = 31383552, O_SSSM = 34529280, O_SSWK = 101638144, O_SSWV = 110026752, O_SFC = 118415360,
                 O_END = 119857152;

constexpr size_t MiB = 1u << 20;
constexpr size_t WS_CTL = 0;
constexpr size_t WS_W = 2 * MiB, W_LAYER = 64 * MiB;
constexpr size_t W_IN = 0, W_A = 28 * MiB, W_SSM = 30 * MiB, W_ATT = 34 * MiB, W_OUT = 36 * MiB, W_XQ = 38 * MiB, W_XKV = 40 * MiB, W_XO = 44 * MiB, W_FFI = 46 * MiB, W_FFO = 58 * MiB;
constexpr size_t WS_Z = 130 * MiB;
constexpr size_t WS_AG = WS_Z;
constexpr size_t WS_HID = WS_Z + 180 * MiB;
constexpr size_t WS_XBC = 578 * MiB;
constexpr size_t WS_YG = 708 * MiB;
constexpr size_t WS_XN = 773 * MiB;
constexpr size_t WS_B1 = 806 * MiB;
constexpr size_t WS_B2 = 839 * MiB;
constexpr size_t WS_B3 = 872 * MiB;
constexpr size_t WS_B4 = 905 * MiB;
constexpr size_t WS_F0 = 938 * MiB;
constexpr size_t WS_F1 = 1003 * MiB;
constexpr size_t WS_KR = 1068 * MiB;
constexpr size_t WS_DT = 1077 * MiB;
constexpr size_t WS_MN = 1080 * MiB, WS_MK = 1084 * MiB, WS_MV = 1088 * MiB;
constexpr size_t WS_VT = 1092 * MiB;
constexpr size_t WS_END = 1100 * MiB;
static_assert((size_t)RPAD * IN_PAD * 2 <= 448 * MiB && (size_t)RPAD * 2 * DFF * 2 <= 180 * MiB && WS_HID + (size_t)RPAD * DFF * 2 <= WS_XBC, "ws map");

struct Params { const float* in[N_IN]; float* out; unsigned char* ws; };

__device__ __forceinline__ float bf2f(unsigned v) { return __uint_as_float(v << 16); }
__device__ __forceinline__ unsigned f2bf(float f) { unsigned u = __float_as_uint(f); return (u + 0x7fffu + ((u >> 16) & 1u)) >> 16; }
__device__ __forceinline__ unsigned pk2(float lo, float hi) { return f2bf(lo) | (f2bf(hi) << 16); }
__device__ __forceinline__ void ld8(const bf16* p, float (&o)[8]) {
    const u32x4 w = *(const u32x4*)p;
    o[0] = bf2f(w.x & 0xffffu); o[1] = bf2f(w.x >> 16); o[2] = bf2f(w.y & 0xffffu); o[3] = bf2f(w.y >> 16);
    o[4] = bf2f(w.z & 0xffffu); o[5] = bf2f(w.z >> 16); o[6] = bf2f(w.w & 0xffffu); o[7] = bf2f(w.w >> 16);
}
__device__ __forceinline__ void st8(bf16* p, const float (&v)[8]) {
    u32x4 w; w.x = pk2(v[0], v[1]); w.y = pk2(v[2], v[3]); w.z = pk2(v[4], v[5]); w.w = pk2(v[6], v[7]); *(u32x4*)p = w;
}
__device__ __forceinline__ void ld8f(const float* p, float (&o)[8]) {
    const f32x4 a = *(const f32x4*)p, b = *(const f32x4*)(p + 4);
    o[0] = a.x; o[1] = a.y; o[2] = a.z; o[3] = a.w; o[4] = b.x; o[5] = b.y; o[6] = b.z; o[7] = b.w;
}
__device__ __forceinline__ void st8f(float* p, const float (&v)[8]) {
    *(f32x4*)p = (f32x4){v[0], v[1], v[2], v[3]}; *(f32x4*)(p + 4) = (f32x4){v[4], v[5], v[6], v[7]};
}
__device__ __forceinline__ float wave_sum(float v) {
#pragma unroll
    for (int o = 1; o < 64; o <<= 1) v += __shfl_xor(v, o);
    return v;
}
__device__ __forceinline__ float wave_max(float v) {
#pragma unroll
    for (int o = 1; o < 64; o <<= 1) v = fmaxf(v, __shfl_xor(v, o));
    return v;
}
__device__ __forceinline__ int tid_opaque() { int t = threadIdx.x; asm volatile("" : "+v"(t)); return t; }
__device__ __forceinline__ float sigmoidf_(float x) { return 1.f / (1.f + __expf(-x)); }
__device__ __forceinline__ float siluf_(float x) { return x / (1.f + __expf(-x)); }
__device__ __forceinline__ float softplusf_(float x) { return x > 20.f ? x : log1pf(expf(x)); }
typedef short bf16x8 __attribute__((ext_vector_type(8)));
typedef float f32x16 __attribute__((ext_vector_type(16)));
typedef float f32x2_t __attribute__((ext_vector_type(2))); typedef __bf16 bf16x2_t __attribute__((ext_vector_type(2)));
#define MFMA32(a, b, c) __builtin_amdgcn_mfma_f32_32x32x16_bf16((a), (b), (c), 0, 0, 0)
#define LASP __attribute__((address_space(3)))
__device__ __forceinline__ unsigned cvtpk(float lo, float hi) { f32x2_t v = {lo, hi}; bf16x2_t b = __builtin_convertvector(v, bf16x2_t); return __builtin_bit_cast(unsigned, b); }
__device__ __forceinline__ bf16x8 pack8(const f32x16& x, const int s) {
    u32x4 w; w.x = cvtpk(x[8 * s], x[8 * s + 1]); w.y = cvtpk(x[8 * s + 2], x[8 * s + 3]); w.z = cvtpk(x[8 * s + 4], x[8 * s + 5]); w.w = cvtpk(x[8 * s + 6], x[8 * s + 7]);
    return __builtin_bit_cast(bf16x8, w);
}
__device__ __forceinline__ int kappa(int rho) { return (rho & ~12) | ((rho & 4) << 1) | ((rho & 8) >> 1); }


__device__ __forceinline__ void ph_xinit(const Params& p) {
    const int tidx = tid_opaque();
    const int lane = tidx & 63, gw = (blockIdx.x * blockDim.x + tidx) >> 6, nw = (gridDim.x * blockDim.x) >> 6;
    bf16* XN = (bf16*)(p.ws + WS_XN); const float* g = p.in[I_NMPRE];
    for (int r = gw; r < R; r += nw) {
        const float* src = r < RPROMPT ? p.in[I_XP] + (size_t)r * D : p.in[I_XS] + (size_t)(r - RPROMPT) * D;
        f32x4 v[4]; float ss = 0.f;
#pragma unroll
        for (int j = 0; j < 4; ++j) { v[j] = *(const f32x4*)(src + lane * 4 + j * 256); ss += v[j].x * v[j].x + v[j].y * v[j].y + v[j].z * v[j].z + v[j].w * v[j].w;
            *(f32x4*)(p.out + (size_t)r * D + lane * 4 + j * 256) = v[j]; }
        const float rstd = rsqrtf(wave_sum(ss) * (1.f / D) + EPS);
#pragma unroll
        for (int j = 0; j < 4; ++j) { const f32x4 gg = *(const f32x4*)(g + lane * 4 + j * 256);
            u32x2 w; w.x = pk2(v[j].x * rstd * gg.x, v[j].y * rstd * gg.y); w.y = pk2(v[j].z * rstd * gg.z, v[j].w * rstd * gg.w);
            *(u32x2*)(XN + (size_t)r * D + lane * 4 + j * 256) = w; }
    }
}
__device__ __forceinline__ void ph_normrows(const float* src, const int rows, const float* g, bf16* dst) {
    const int tidx = tid_opaque();
    const int lane = tidx & 63, gw = (blockIdx.x * blockDim.x + tidx) >> 6, nw = (gridDim.x * blockDim.x) >> 6;
    for (int r = gw; r < rows; r += nw) {
        f32x4 v[4]; float ss = 0.f;
#pragma unroll
        for (int j = 0; j < 4; ++j) { v[j] = *(const f32x4*)(src + (size_t)r * D + lane * 4 + j * 256); ss += v[j].x * v[j].x + v[j].y * v[j].y + v[j].z * v[j].z + v[j].w * v[j].w; }
        const float rstd = rsqrtf(wave_sum(ss) * (1.f / D) + EPS);
#pragma unroll
        for (int j = 0; j < 4; ++j) { const f32x4 gg = *(const f32x4*)(g + lane * 4 + j * 256);
            u32x2 w; w.x = pk2(v[j].x * rstd * gg.x, v[j].y * rstd * gg.y); w.y = pk2(v[j].z * rstd * gg.z, v[j].w * rstd * gg.w);
            *(u32x2*)(dst + (size_t)r * D + lane * 4 + j * 256) = w; }
    }
}

struct EpiStoreBf16 { bf16* O; long ldo; __device__ __forceinline__ void operator()(int row, int col, f32x4 v) const {
    u32x2 w; w.x = pk2(v.x, v.y); w.y = pk2(v.z, v.w); *(u32x2*)(O + (size_t)row * ldo + col) = w; } };
struct EpiStoreF32 { float* O; long ldo; __device__ __forceinline__ void operator()(int row, int col, f32x4 v) const { *(f32x4*)(O + (size_t)row * ldo + col) = v; } };
struct EpiMemKV { float* outk; float* outv; bf16* MK; bf16* MVt; __device__ __forceinline__ void operator()(int row, int col, f32x4 v) const {
    if (col < 1024) { u32x2 w; w.x = pk2(v.x, v.y); w.y = pk2(v.z, v.w); *(f32x4*)(outk + (size_t)row * 1024 + col) = v; *(u32x2*)(MK + (size_t)row * 1024 + col) = w; }
    else { const int c = col - 1024; *(f32x4*)(outv + (size_t)row * 1024 + c) = v;
        bf16* t = MVt + ((size_t)((row >> 8) * XH + (c >> 8)) * XHD + (c & 255)) * MEM + (row & 255);
        t[0] = (bf16)f2bf(v.x); t[MEM] = (bf16)f2bf(v.y); t[2 * MEM] = (bf16)f2bf(v.z); t[3 * MEM] = (bf16)f2bf(v.w); } } };
template <int WHICH> struct EpiGate { const bf16* Z; float* MIXF; bf16* MIX; __device__ __forceinline__ void operator()(int row, int col, f32x4 v) const {
    const u32x2 gz = *(const u32x2*)(Z + (size_t)row * IN_PAD + C_G + WHICH * D + col);
    f32x4 g; g.x = sigmoidf_(bf2f(gz.x & 0xffffu)); g.y = sigmoidf_(bf2f(gz.x >> 16)); g.z = sigmoidf_(bf2f(gz.y & 0xffffu)); g.w = sigmoidf_(bf2f(gz.y >> 16));
    f32x4 t = g * v; float* mp = MIXF + (size_t)row * D + col;
    if (WHICH > 0) t += *(const f32x4*)mp;
    if (WHICH < 2) *(f32x4*)mp = t;
    else { u32x2 w; w.x = pk2(t.x, t.y); w.y = pk2(t.z, t.w); *(u32x2*)(MIX + (size_t)row * D + col) = w; } } };

__device__ __forceinline__ void ph_mixa(const Params& p, const int l) {
    const int tidx = tid_opaque();
    const bf16* Z = (const bf16*)(p.ws + WS_Z); bf16* UA = (bf16*)(p.ws + WS_B1);
    const float* cw = p.in[I_CAW] + (size_t)l * 3 * D;
    const int nitems = R * 128;
    for (int it = blockIdx.x * blockDim.x + tidx; it < nitems; it += gridDim.x * blockDim.x) {
        const int r = it >> 7, c0 = (it & 127) * 8;
        float w0[8], w1[8], w2[8], a[8], b[8], gb[8], c[3][8], u[8];
        const bf16* zr = Z + (size_t)r * IN_PAD;
        ld8(zr + C_GC + c0, a); ld8(zr + C_VA + c0, b); ld8(zr + C_GB + c0, gb);
#pragma unroll
        for (int i = 0; i < 8; ++i) w2[i] = a[i] * b[i];
        if (r < RPROMPT) {
            const int t = r & (SEQ - 1);
            if (t >= 1) { ld8(zr - IN_PAD + C_GC + c0, a); ld8(zr - IN_PAD + C_VA + c0, b);
#pragma unroll
                for (int i = 0; i < 8; ++i) w1[i] = a[i] * b[i]; }
            else {
#pragma unroll
                for (int i = 0; i < 8; ++i) w1[i] = 0.f; }
            if (t >= 2) { ld8(zr - 2 * IN_PAD + C_GC + c0, a); ld8(zr - 2 * IN_PAD + C_VA + c0, b);
#pragma unroll
                for (int i = 0; i < 8; ++i) w0[i] = a[i] * b[i]; }
            else {
#pragma unroll
                for (int i = 0; i < 8; ++i) w0[i] = 0.f; }
            if (t >= SEQ - 2) st8f(p.out + O_PCA + (((size_t)l * BATCH + (r >> 11)) * 2 + (t - (SEQ - 2))) * D + c0, w2);
        } else {
            const int bb = r - RPROMPT; const float* buf = p.in[I_SCA] + ((size_t)l * DB + bb) * 2 * D;
            ld8f(buf + c0, w0); ld8f(buf + D + c0, w1);
            float* so = p.out + O_SCA + ((size_t)l * DB + bb) * 2 * D;
            st8f(so + c0, w1); st8f(so + D + c0, w2);
        }
        ld8f(cw + c0, c[0]); ld8f(cw + D + c0, c[1]); ld8f(cw + 2 * D + c0, c[2]);
#pragma unroll
        for (int i = 0; i < 8; ++i) u[i] = gb[i] * (c[0][i] * w0[i] + c[1][i] * w1[i] + c[2][i] * w2[i]);
        st8(UA + (size_t)r * D + c0, u);
    }
}
__device__ __forceinline__ void ph_ssmconv(const Params& p, const int l) {
    const int tidx = tid_opaque();
    const bf16* Z = (const bf16*)(p.ws + WS_Z); bf16* XBC = (bf16*)(p.ws + WS_XBC);
    const float* cw = p.in[I_SCW] + (size_t)l * 4 * CD; const float* cb = p.in[I_SCB] + (size_t)l * CD;
    const int nitems = R * (CD / 8);
    for (int it = blockIdx.x * blockDim.x + tidx; it < nitems; it += gridDim.x * blockDim.x) {
        const int r = it / (CD / 8), c0 = (it % (CD / 8)) * 8;
        float x[4][8], c[8], acc[8];
        const bf16* zr = Z + (size_t)r * IN_PAD + C_XBC + c0;
        ld8(zr, x[3]);
        if (r < RPROMPT) {
            const int t = r & (SEQ - 1);
#pragma unroll
            for (int k = 0; k < 3; ++k) {
                if (t - 3 + k >= 0) ld8(zr - (size_t)(3 - k) * IN_PAD, x[k]);
                else {
#pragma unroll
                    for (int i = 0; i < 8; ++i) x[k][i] = 0.f; }
            }
            if (t >= SEQ - 3) st8f(p.out + O_PSC + (((size_t)l * BATCH + (r >> 11)) * 3 + (t - (SEQ - 3))) * CD + c0, x[3]);
        } else {
            const int bb = r - RPROMPT; const float* buf = p.in[I_SSC] + ((size_t)l * DB + bb) * 3 * CD;
            ld8f(buf + c0, x[0]); ld8f(buf + CD + c0, x[1]); ld8f(buf + 2 * CD + c0, x[2]);
            float* so = p.out + O_SSC + ((size_t)l * DB + bb) * 3 * CD;
            st8f(so + c0, x[1]); st8f(so + CD + c0, x[2]); st8f(so + 2 * CD + c0, x[3]);
        }
        ld8f(cb + c0, acc);
#pragma unroll
        for (int k = 0; k < 4; ++k) { ld8f(cw + (size_t)k * CD + c0, c);
#pragma unroll
            for (int i = 0; i < 8; ++i) acc[i] += c[i] * x[k][i]; }
#pragma unroll
        for (int i = 0; i < 8; ++i) acc[i] = siluf_(acc[i]);
        st8(XBC + (size_t)r * CD + c0, acc);
    }
}
__device__ __forceinline__ void ph_dt(const Params& p, const int l) {
    const int tidx = tid_opaque();
    const bf16* Z = (const bf16*)(p.ws + WS_Z); float* DT = (float*)(p.ws + WS_DT);
    const float* dtb = p.in[I_DTB] + l * H_SSM;
    for (int it = blockIdx.x * blockDim.x + tidx; it < R * H_SSM; it += gridDim.x * blockDim.x) {
        const int r = it >> 5, h = it & 31;
        DT[it] = softplusf_(bf2f(Z[(size_t)r * IN_PAD + C_DT + h]) + dtb[h]);
    }
}
__constant__ float c_inv_freq[8] = {1.0f, 0.19392274474868576f, 0.03760603093086393f, 0.007292664737217109f, 0.001414213562373095f, 0.0002742481756762073f, 5.318295896944988e-05f, 1.031338537721246e-05f};
__device__ __forceinline__ void ph_rope(const Params& p, const int l) {
    const int tidx = tid_opaque();
    const bf16* Z = (const bf16*)(p.ws + WS_Z); bf16* QR = (bf16*)(p.ws + WS_B2); bf16* KR = (bf16*)(p.ws + WS_KR);
    for (int it = blockIdx.x * blockDim.x + tidx; it < R * 20; it += gridDim.x * blockDim.x) {
        const int r = it / 20, hs = it % 20;
        const bool isq = hs < 16; const int hh = isq ? hs : hs - 16;
        const bf16* src = Z + (size_t)r * IN_PAD + (isq ? C_Q : C_K) + hh * HD;
        bf16* dst = isq ? QR + (size_t)r * D + hh * HD : KR + (size_t)r * 256 + hh * HD;
        const int t = r < RPROMPT ? (r & (SEQ - 1)) : 0;
        const float pos = r < RPROMPT ? (float)t : (float)PAST_LEN;
        float v[8][8];
#pragma unroll
        for (int j = 0; j < 8; ++j) ld8(src + j * 8, v[j]);
        float x1[8], x2[8];
#pragma unroll
        for (int i = 0; i < 8; ++i) { float sn, cs; sincosf(pos * c_inv_freq[i], &sn, &cs); x1[i] = v[0][i] * cs - v[1][i] * sn; x2[i] = v[1][i] * cs + v[0][i] * sn; }
#pragma unroll
        for (int i = 0; i < 8; ++i) { v[0][i] = x1[i]; v[1][i] = x2[i]; }
#pragma unroll
        for (int j = 0; j < 8; ++j) st8(dst + j * 8, v[j]);
        if (!isq) {
            float vv[8][8];
#pragma unroll
            for (int j = 0; j < 8; ++j) ld8(Z + (size_t)r * IN_PAD + C_V + hh * HD + j * 8, vv[j]);
            if (r < RPROMPT) { bf16* vt = (bf16*)(p.ws + WS_VT) + ((size_t)((r >> 11) * KV_ATT + hh) * HD) * SEQ + t;
#pragma unroll
                for (int j = 0; j < 8; ++j)
#pragma unroll
                    for (int i = 0; i < 8; ++i) vt[(size_t)(j * 8 + i) * SEQ] = (bf16)f2bf(vv[j][i]); }
            float* ok = nullptr; float* ov = nullptr;
            if (r < RPROMPT) { if (t >= SEQ - WINDOW) { const size_t o = ((((size_t)l * BATCH + (r >> 11)) * WINDOW + (t - (SEQ - WINDOW))) * KV_ATT + hh) * HD; ok = p.out + O_PSWK + o; ov = p.out + O_PSWV + o; } }
            else { const size_t o = ((((size_t)l * DB + (r - RPROMPT)) * WINDOW + (WINDOW - 1)) * KV_ATT + hh) * HD; ok = p.out + O_SSWK + o; ov = p.out + O_SSWV + o; }
            if (ok) {
#pragma unroll
                for (int j = 0; j < 8; ++j) { st8f(ok + j * 8, v[j]); st8f(ov + j * 8, vv[j]); }
            }
        }
    }
}
__device__ __forceinline__ void ph_swashift(const Params& p, const int l) {
    const int tidx = tid_opaque();
    const size_t per_b = (size_t)WINDOW * KV_ATT * HD, n4 = (size_t)DB * (WINDOW - 1) * KV_ATT * HD / 4, row4 = (size_t)(WINDOW - 1) * KV_ATT * HD / 4;
    const float* ck = p.in[I_SWK] + (size_t)l * DB * per_b; const float* cv = p.in[I_SWV] + (size_t)l * DB * per_b;
    float* ok = p.out + O_SSWK + (size_t)l * DB * per_b; float* ov = p.out + O_SSWV + (size_t)l * DB * per_b;
    for (size_t i = blockIdx.x * (size_t)blockDim.x + tidx; i < n4; i += (size_t)gridDim.x * blockDim.x) {
        const size_t b = i / row4, j = i % row4;
        *(f32x4*)(ok + b * per_b + j * 4) = *(const f32x4*)(ck + b * per_b + KV_ATT * HD + j * 4);
        *(f32x4*)(ov + b * per_b + j * 4) = *(const f32x4*)(cv + b * per_b + KV_ATT * HD + j * 4);
    }
}

typedef short v4i16_t __attribute__((ext_vector_type(4)));
__device__ __forceinline__ v4i16_t tr4(LASP unsigned char* img, int S, int rowbase, int col0, int lane) {
    const int blk = (lane >> 4) & 1, q = (lane & 15) >> 2, pp = lane & 3;
    return __builtin_amdgcn_ds_read_tr16_b64_v4i16((LASP v4i16_t*)(img + (rowbase + q) * S + (col0 + 16 * blk + 4 * pp) * 2));
}
__device__ __forceinline__ bf16x8 tr8(LASP unsigned char* img, int S, int rowbase, int col0, int lane) {
    const v4i16_t lo = tr4(img, S, rowbase, col0, lane), hi = tr4(img, S, rowbase + 4, col0, lane);
    return __builtin_shufflevector(lo, hi, 0, 1, 2, 3, 4, 5, 6, 7);
}
constexpr int SSD_SB = 320, SSD_SX = 192, SSD_SH = 272;
constexpr int SSD_BIMG = 0, SSD_XIMG = 40960, SSD_XSIMG = 65536, SSD_HIMG = 90112, SSD_CS = 107520, SSD_DT = 108032, SSD_LDS_END = 108544;
__device__ __forceinline__ void ph_ssd_prompt(const Params& p, const int l, LASP unsigned char* lds) {
    const int tidx = tid_opaque();
    const bf16* Z = (const bf16*)(p.ws + WS_Z); const bf16* XBC = (const bf16*)(p.ws + WS_XBC); const float* DT = (const float*)(p.ws + WS_DT); bf16* YG = (bf16*)(p.ws + WS_YG);
    const int lane = tidx & 63, w = tidx >> 6, r32 = lane & 31, hk = lane >> 5;
    LASP unsigned char* Bimg = lds + SSD_BIMG; LASP unsigned char* Ximg = lds + SSD_XIMG; LASP unsigned char* XSimg = lds + SSD_XSIMG; LASP unsigned char* Himg = lds + SSD_HIMG;
    LASP float* csl = (LASP float*)(lds + SSD_CS); LASP float* dtl = (LASP float*)(lds + SSD_DT);
    const int wp = w >> 1, jt = wp == 0 ? 0 : (wp == 1 ? 1 : (wp == 2 ? 3 : 2)), pt = w & 1;
    const int pt2 = w >> 2, nt = w & 3;
    for (int unit = blockIdx.x; unit < BATCH * H_SSM; unit += gridDim.x) {
        const int b = unit >> 5, hh = unit & 31, g = hh >> 2;
        const float A = -expf(p.in[I_ALOG][l * H_SSM + hh]), Dh = p.in[I_SSD][l * H_SSM + hh];
        const size_t row0 = (size_t)b * SEQ;
        f32x16 hacc;
#pragma unroll
        for (int i = 0; i < 16; ++i) hacc[i] = 0.f;
        const int bs = tidx >> 4, bc = tidx & 15, xs = tidx >> 3, xc = tidx & 7;
        u32x4 breg[4], xreg[2]; float dlo, dhi; bf16x8 cf[8];
        {   const size_t r0 = row0;
#pragma unroll
            for (int ps = 0; ps < 4; ++ps) breg[ps] = *(const u32x4*)(XBC + (r0 + bs + 32 * ps) * CD + DSSM + g * N_SSM + 8 * bc);
#pragma unroll
            for (int ps = 0; ps < 2; ++ps) xreg[ps] = *(const u32x4*)(XBC + (r0 + xs + 64 * ps) * CD + hh * P_SSM + 8 * xc);
            dlo = DT[(r0 + lane) * H_SSM + hh]; dhi = DT[(r0 + 64 + lane) * H_SSM + hh];
#pragma unroll
            for (int ks = 0; ks < 8; ++ks) cf[ks] = *(const bf16x8*)(XBC + (r0 + 32 * jt + r32) * CD + DSSM + G_SSM * N_SSM + g * N_SSM + 16 * ks + 8 * hk);
        }
        __syncthreads();
#pragma unroll
        for (int i = 0; i < 16; ++i) *(LASP bf16*)(Himg + (32 * pt2 + (i & 3) + 8 * (i >> 2) + 4 * hk) * SSD_SH + (32 * nt + r32) * 2) = 0;
#pragma unroll 1
        for (int c = 0; c < SEQ / 128; ++c) {
            const size_t r0 = row0 + (size_t)c * 128;
            float clo = dlo * A, chi = dhi * A;
#pragma unroll
            for (int o = 1; o < 64; o <<= 1) { const float t0 = __shfl_up(clo, o), t1 = __shfl_up(chi, o); if (lane >= o) { clo += t0; chi += t1; } }
            chi += __shfl(clo, 63);
            const float cs_last = __shfl(chi, 63);
#pragma unroll
            for (int ps = 0; ps < 4; ++ps) *(LASP u32x4*)(Bimg + (bs + 32 * ps) * SSD_SB + 16 * bc) = breg[ps];
#pragma unroll
            for (int ps = 0; ps < 2; ++ps) { const int s_ = xs + 64 * ps;
                *(LASP u32x4*)(Ximg + s_ * SSD_SX + 16 * xc) = xreg[ps];
                const float css = ps == 0 ? __shfl(clo, xs) : __shfl(chi, xs), dts = ps == 0 ? __shfl(dlo, xs) : __shfl(dhi, xs);
                const float ws_ = dts * __expf(cs_last - css);
                const u32x4 xv = xreg[ps]; u32x4 o;
                o.x = cvtpk(bf2f(xv.x & 0xffffu) * ws_, bf2f(xv.x >> 16) * ws_); o.y = cvtpk(bf2f(xv.y & 0xffffu) * ws_, bf2f(xv.y >> 16) * ws_);
                o.z = cvtpk(bf2f(xv.z & 0xffffu) * ws_, bf2f(xv.z >> 16) * ws_); o.w = cvtpk(bf2f(xv.w & 0xffffu) * ws_, bf2f(xv.w >> 16) * ws_);
                *(LASP u32x4*)(XSimg + s_ * SSD_SX + 16 * xc) = o; }
            if (w == 0) { csl[lane] = clo; csl[64 + lane] = chi; dtl[lane] = dlo; dtl[64 + lane] = dhi; }
            if (c + 1 < SEQ / 128) { const size_t rn = r0 + 128;
#pragma unroll
                for (int ps = 0; ps < 4; ++ps) breg[ps] = *(const u32x4*)(XBC + (rn + bs + 32 * ps) * CD + DSSM + g * N_SSM + 8 * bc);
#pragma unroll
                for (int ps = 0; ps < 2; ++ps) xreg[ps] = *(const u32x4*)(XBC + (rn + xs + 64 * ps) * CD + hh * P_SSM + 8 * xc);
                dlo = DT[(rn + lane) * H_SSM + hh]; dhi = DT[(rn + 64 + lane) * H_SSM + hh];
            }
            u32x2 zg[4];
#pragma unroll
            for (int g4 = 0; g4 < 4; ++g4) zg[g4] = *(const u32x2*)(Z + (r0 + 32 * jt + r32) * IN_PAD + C_ZS + hh * P_SSM + 32 * pt + 8 * g4 + 4 * hk);
            __syncthreads();
            const float cs_l = csl[32 * jt + r32];
            f32x16 acc1;
#pragma unroll
            for (int i = 0; i < 16; ++i) acc1[i] = 0.f;
#pragma unroll 1
            for (int it = 0; it <= jt; ++it) {
                f32x16 X;
#pragma unroll
                for (int i = 0; i < 16; ++i) X[i] = 0.f;
#pragma unroll
                for (int ks = 0; ks < 8; ++ks) { const bf16x8 bf_ = *(LASP bf16x8*)(Bimg + (32 * it + kappa(r32)) * SSD_SB + 32 * ks + 16 * hk); X = MFMA32(bf_, cf[ks], X); }
#pragma unroll
                for (int a = 0; a < 2; ++a) {
                    const int sb = 32 * it + 16 * a + 8 * hk;
                    const f32x4 c0 = *(LASP f32x4*)(csl + sb), c1 = *(LASP f32x4*)(csl + sb + 4), d0 = *(LASP f32x4*)(dtl + sb), d1 = *(LASP f32x4*)(dtl + sb + 4);
#pragma unroll
                    for (int e = 0; e < 8; ++e) { const float css = e < 4 ? c0[e & 3] : c1[e & 3], dts = e < 4 ? d0[e & 3] : d1[e & 3];
                        const int sl = 16 * a + 8 * hk + e;
                        float wv = X[8 * a + e] * __expf(cs_l - css) * dts;
                        if (it == jt) { wv = sl <= r32 ? wv : 0.f; if (sl == r32) wv += Dh; }
                        X[8 * a + e] = wv; }
                }
#pragma unroll
                for (int a = 0; a < 2; ++a) { const bf16x8 pf_ = pack8(X, a); const bf16x8 xf_ = tr8(Ximg, SSD_SX, 32 * it + 16 * a + 8 * hk, 32 * pt, lane); acc1 = MFMA32(xf_, pf_, acc1); }
            }
            f32x16 acc2;
#pragma unroll
            for (int i = 0; i < 16; ++i) acc2[i] = 0.f;
#pragma unroll
            for (int ks = 0; ks < 8; ++ks) { const bf16x8 hf_ = *(LASP bf16x8*)(Himg + (32 * pt + r32) * SSD_SH + 32 * ks + 16 * hk); acc2 = MFMA32(hf_, cf[ks], acc2); }
            if (c + 1 < SEQ / 128) {
#pragma unroll
                for (int ks = 0; ks < 8; ++ks) cf[ks] = *(const bf16x8*)(XBC + (r0 + 128 + 32 * jt + r32) * CD + DSSM + G_SSM * N_SSM + g * N_SSM + 16 * ks + 8 * hk);
            }
            {   const float el = __expf(cs_l); bf16* yp = YG + (r0 + 32 * jt + r32) * DSSM + hh * P_SSM + 32 * pt + 4 * hk;
#pragma unroll
                for (int g4 = 0; g4 < 4; ++g4) {
                    const float y0 = acc1[4 * g4] + el * acc2[4 * g4], y1 = acc1[4 * g4 + 1] + el * acc2[4 * g4 + 1], y2 = acc1[4 * g4 + 2] + el * acc2[4 * g4 + 2], y3 = acc1[4 * g4 + 3] + el * acc2[4 * g4 + 3];
                    const float z0 = bf2f(zg[g4].x & 0xffffu), z1 = bf2f(zg[g4].x >> 16), z2 = bf2f(zg[g4].y & 0xffffu), z3 = bf2f(zg[g4].y >> 16);
                    u32x2 o; o.x = cvtpk(y0 * siluf_(z0), y1 * siluf_(z1)); o.y = cvtpk(y2 * siluf_(z2), y3 * siluf_(z3)); *(u32x2*)(yp + 8 * g4) = o; }
            }
            const float dec = __expf(cs_last);
#pragma unroll
            for (int i = 0; i < 16; ++i) hacc[i] *= dec;
#pragma unroll
            for (int ks = 0; ks < 8; ++ks) { const bf16x8 af_ = tr8(XSimg, SSD_SX, 16 * ks + 8 * hk, 32 * pt2, lane); const bf16x8 bf_ = tr8(Bimg, SSD_SB, 16 * ks + 8 * hk, 32 * nt, lane); hacc = MFMA32(af_, bf_, hacc); }
            __syncthreads();
#pragma unroll
            for (int i = 0; i < 16; ++i) *(LASP bf16*)(Himg + (32 * pt2 + (i & 3) + 8 * (i >> 2) + 4 * hk) * SSD_SH + (32 * nt + r32) * 2) = (bf16)f2bf(hacc[i]);
        }
        float* so = p.out + O_PSSM + (((size_t)l * BATCH + b) * H_SSM + hh) * P_SSM * N_SSM;
#pragma unroll
        for (int i = 0; i < 16; ++i) so[(size_t)(32 * pt2 + (i & 3) + 8 * (i >> 2) + 4 * hk) * N_SSM + 32 * nt + r32] = hacc[i];
        __syncthreads();
    }
}

__device__ __forceinline__ void ph_ssd(const Params& p, const int l) {
    const int tidx = tid_opaque();
    const bf16* Z = (const bf16*)(p.ws + WS_Z); const bf16* XBC = (const bf16*)(p.ws + WS_XBC); const float* DT = (const float*)(p.ws + WS_DT); bf16* YG = (bf16*)(p.ws + WS_YG);
    const int tid = tidx, pp = tid >> 3, nq = tid & 7;
    const int nunits = BATCH * H_SSM + DB * H_SSM;
    for (int unit = BATCH * H_SSM + blockIdx.x; unit < nunits; unit += gridDim.x) {
        const bool smp = unit >= BATCH * H_SSM;
        const int bb = smp ? (unit - BATCH * H_SSM) / H_SSM : unit / H_SSM, hh = unit % H_SSM, g = hh >> 2;
        const float A = -expf(p.in[I_ALOG][l * H_SSM + hh]), Dh = p.in[I_SSD][l * H_SSM + hh];
        float h[16];
        if (smp) { const float* s0 = p.in[I_SSM] + ((((size_t)l * DB + bb) * H_SSM + hh) * P_SSM + pp) * N_SSM + nq * 16;
#pragma unroll
            for (int i = 0; i < 4; ++i) { const f32x4 v = *(const f32x4*)(s0 + 4 * i); h[4 * i] = v.x; h[4 * i + 1] = v.y; h[4 * i + 2] = v.z; h[4 * i + 3] = v.w; } }
        else {
#pragma unroll
            for (int i = 0; i < 16; ++i) h[i] = 0.f; }
        const int r0 = smp ? RPROMPT + bb : bb * SEQ, L = smp ? 1 : SEQ;
        for (int t = 0; t < L; ++t) {
            const int r = r0 + t;
            const bf16* xr = XBC + (size_t)r * CD;
            const float x = bf2f(xr[hh * P_SSM + pp]), dt = DT[r * H_SSM + hh];
            float Bv[16], Cv[16];
            { float t0[8], t1[8]; ld8(xr + DSSM + g * N_SSM + nq * 16, t0); ld8(xr + DSSM + g * N_SSM + nq * 16 + 8, t1);
#pragma unroll
              for (int i = 0; i < 8; ++i) { Bv[i] = t0[i]; Bv[8 + i] = t1[i]; }
              ld8(xr + DSSM + G_SSM * N_SSM + g * N_SSM + nq * 16, t0); ld8(xr + DSSM + G_SSM * N_SSM + g * N_SSM + nq * 16 + 8, t1);
#pragma unroll
              for (int i = 0; i < 8; ++i) { Cv[i] = t0[i]; Cv[8 + i] = t1[i]; } }
            const float dA = expf(dt * A), dtx = dt * x;
            float y = 0.f;
#pragma unroll
            for (int i = 0; i < 16; ++i) { h[i] = h[i] * dA + dtx * Bv[i]; y += Cv[i] * h[i]; }
            y += __shfl_xor(y, 1); y += __shfl_xor(y, 2); y += __shfl_xor(y, 4);
            if (nq == 0) { const float yo = y + x * Dh; const float zs = bf2f(Z[(size_t)r * IN_PAD + C_ZS + hh * P_SSM + pp]); YG[(size_t)r * DSSM + hh * P_SSM + pp] = (bf16)f2bf(yo * siluf_(zs)); }
        }
        float* so = (smp ? p.out + O_SSSM + ((((size_t)l * DB + bb) * H_SSM + hh) * P_SSM + pp) * N_SSM : p.out + O_PSSM + ((((size_t)l * BATCH + bb) * H_SSM + hh) * P_SSM + pp) * N_SSM) + nq * 16;
#pragma unroll
        for (int i = 0; i < 4; ++i) *(f32x4*)(so + 4 * i) = (f32x4){h[4 * i], h[4 * i + 1], h[4 * i + 2], h[4 * i + 3]};
    }
}
__device__ __forceinline__ void ph_normyg(const Params& p, const int l) {
    const int tidx = tid_opaque();
    bf16* YG = (bf16*)(p.ws + WS_YG); const float* g = p.in[I_SSN] + (size_t)l * DSSM;
    const int lane = tidx & 63, gw = (blockIdx.x * blockDim.x + tidx) >> 6, nw = (gridDim.x * blockDim.x) >> 6;
    for (int r = gw; r < R; r += nw) {
        float v[4][8]; float ss = 0.f;
#pragma unroll
        for (int j = 0; j < 4; ++j) { ld8(YG + (size_t)r * DSSM + lane * 8 + j * 512, v[j]);
#pragma unroll
            for (int i = 0; i < 8; ++i) ss += v[j][i] * v[j][i]; }
        const float rstd = rsqrtf(wave_sum(ss) * (1.f / DSSM) + EPS);
#pragma unroll
        for (int j = 0; j < 4; ++j) { float gg[8]; ld8f(g + lane * 8 + j * 512, gg);
#pragma unroll
            for (int i = 0; i < 8; ++i) v[j][i] = v[j][i] * rstd * gg[i];
            st8(YG + (size_t)r * DSSM + lane * 8 + j * 512, v[j]); }
    }
}

__device__ __forceinline__ void ph_swa_prompt(const Params& p, const int l) {
    const int tidx = tid_opaque();
    const bf16* QR = (const bf16*)(p.ws + WS_B2); const bf16* KR = (const bf16*)(p.ws + WS_KR); const bf16* Vt = (const bf16*)(p.ws + WS_VT); bf16* O = (bf16*)(p.ws + WS_B3);
    const int lane = tidx & 63, w = tidx >> 6, r32 = lane & 31, hk = lane >> 5;
    const float L2E = 1.4426950408889634f;
    for (int unit = blockIdx.x; unit < BATCH * 16 * KV_ATT; unit += gridDim.x) {
        const int b = unit >> 6, blk = (unit >> 2) & 15, kv = unit & 3, hq = kv * 4 + (w >> 1);
        const float sink = p.in[I_SINK][l * H_ATT + hq];
#pragma unroll 1
        for (int tt = 0; tt < 2; ++tt) {
            const int tq = 2 * (w & 1) + tt;
            const size_t rq = (size_t)b * SEQ + blk * WINDOW + 32 * tq + r32;
            bf16x8 qf[4];
#pragma unroll
            for (int ks = 0; ks < 4; ++ks) qf[ks] = *(const bf16x8*)(QR + rq * D + hq * HD + 16 * ks + 8 * hk);
            f32x16 S[5];
            const int t0 = (blk - 1) * WINDOW + 32 * tq;
            const int j0 = blk == 0 ? 4 - tq : 0;
#pragma unroll
            for (int j = 0; j < 5; ++j) {
                f32x16 acc;
#pragma unroll
                for (int i = 0; i < 16; ++i) acc[i] = 0.f;
                if (j >= j0) {
                    const bf16* kp = KR + ((size_t)b * SEQ + t0 + 32 * j + kappa(r32)) * 256 + kv * HD + 8 * hk;
#pragma unroll
                    for (int ks = 0; ks < 4; ++ks) { const bf16x8 kf = *(const bf16x8*)(kp + 16 * ks); acc = MFMA32(kf, qf[ks], acc); }
                }
                S[j] = acc;
            }
            float m = sink;
#pragma unroll
            for (int j = 0; j < 5; ++j)
#pragma unroll
                for (int i = 0; i < 16; ++i) { const int kk = 16 * (i >> 3) + 8 * hk + (i & 7);
                    bool valid = j >= j0; if (j == 0) valid = valid && (kk > r32); if (j == 4) valid = valid && (kk <= r32);
                    const float sv = valid ? S[j][i] * 0.125f : -INFINITY; S[j][i] = sv; m = fmaxf(m, sv); }
            m = fmaxf(m, __shfl_xor(m, 32));
            float sum = 0.f;
#pragma unroll
            for (int j = 0; j < 5; ++j)
#pragma unroll
                for (int i = 0; i < 16; ++i) { const float e = __builtin_amdgcn_exp2f((S[j][i] - m) * L2E); S[j][i] = e; sum += e; }
            sum += __shfl_xor(sum, 32);
            sum += __builtin_amdgcn_exp2f((sink - m) * L2E);
            const float inv = 1.f / sum;
            bf16x8 pf[5][2];
#pragma unroll
            for (int j = 0; j < 5; ++j) { pf[j][0] = pack8(S[j], 0); pf[j][1] = pack8(S[j], 1); }
            bf16* op = O + rq * D + hq * HD + 4 * hk;
#pragma unroll
            for (int dt = 0; dt < 2; ++dt) {
                f32x16 o;
#pragma unroll
                for (int i = 0; i < 16; ++i) o[i] = 0.f;
                const bf16* vp = Vt + ((size_t)(b * KV_ATT + kv) * HD + 32 * dt + r32) * SEQ + t0 + 8 * hk;
#pragma unroll
                for (int j = 0; j < 5; ++j)
                    if (j >= j0) {
#pragma unroll
                        for (int s = 0; s < 2; ++s) { const bf16x8 vf = *(const bf16x8*)(vp + 32 * j + 16 * s); o = MFMA32(vf, pf[j][s], o); }
                    }
#pragma unroll
                for (int g = 0; g < 4; ++g) { u32x2 wv; wv.x = cvtpk(o[4 * g] * inv, o[4 * g + 1] * inv); wv.y = cvtpk(o[4 * g + 2] * inv, o[4 * g + 3] * inv); *(u32x2*)(op + 32 * dt + 8 * g) = wv; }
            }
        }
    }
}

__device__ __forceinline__ void ph_swa(const Params& p, const int l) {
    const int tidx = tid_opaque();
    const bf16* Z = (const bf16*)(p.ws + WS_Z); const bf16* QR = (const bf16*)(p.ws + WS_B2); const bf16* KR = (const bf16*)(p.ws + WS_KR); bf16* O = (bf16*)(p.ws + WS_B3);
    const int lane = tidx & 63, gw = (blockIdx.x * blockDim.x + tidx) >> 6, nw = (gridDim.x * blockDim.x) >> 6;
    for (int unit = RPROMPT * H_ATT + gw; unit < R * H_ATT; unit += nw) {
        const int r = unit >> 4, hh = unit & 15, kv = hh >> 2;
        const bool smp = r >= RPROMPT; const int t = smp ? 0 : (r & (SEQ - 1)), bb = r - RPROMPT;
        const float qv = bf2f(QR[(size_t)r * D + hh * HD + lane]);
        const float* ck = p.in[I_SWK] + (((size_t)l * DB + (smp ? bb : 0)) * WINDOW) * KV_ATT * HD;
        const float* cv = p.in[I_SWV] + (((size_t)l * DB + (smp ? bb : 0)) * WINDOW) * KV_ATT * HD;
        float s[2] = {0.f, 0.f};
#pragma unroll 1
        for (int half = 0; half < 2; ++half) {
            const int w = lane + 64 * half;
            float kk[64]; bool valid = true;
            if (!smp) { valid = (t - (WINDOW - 1) + w) >= 0;
                const bf16* kr = KR + (size_t)(valid ? r - (WINDOW - 1) + w : r) * 256 + kv * HD;
#pragma unroll
                for (int j = 0; j < 8; ++j) { float tmp[8]; ld8(kr + j * 8, tmp);
#pragma unroll
                    for (int i = 0; i < 8; ++i) kk[j * 8 + i] = tmp[i]; } }
            else if (w < WINDOW - 1) { const float* kr = ck + ((size_t)(w + 1) * KV_ATT + kv) * HD;
#pragma unroll
                for (int j = 0; j < 8; ++j) { float tmp[8]; ld8f(kr + j * 8, tmp);
#pragma unroll
                    for (int i = 0; i < 8; ++i) kk[j * 8 + i] = tmp[i]; } }
            else { const bf16* kr = KR + (size_t)r * 256 + kv * HD;
#pragma unroll
                for (int j = 0; j < 8; ++j) { float tmp[8]; ld8(kr + j * 8, tmp);
#pragma unroll
                    for (int i = 0; i < 8; ++i) kk[j * 8 + i] = tmp[i]; } }
            float acc = 0.f;
#pragma unroll
            for (int d = 0; d < 64; ++d) acc += __shfl(qv, d) * kk[d];
            const float sv = valid ? acc * 0.125f : -INFINITY; if (half == 0) s[0] = sv; else s[1] = sv;
        }
        const float sink = p.in[I_SINK][l * H_ATT + hh];
        const float m = fmaxf(wave_max(fmaxf(s[0], s[1])), sink);
        const float e0 = __expf(s[0] - m), e1 = __expf(s[1] - m);
        const float den = wave_sum(e0 + e1) + __expf(sink - m);
        const float p0 = e0 / den, p1 = e1 / den;
        float o = 0.f;
        for (int w = 0; w < WINDOW; ++w) {
            const float pw = w < 64 ? __shfl(p0, w) : __shfl(p1, w - 64);
            float vv;
            if (!smp) { const bool valid = (t - (WINDOW - 1) + w) >= 0; vv = valid ? bf2f(Z[(size_t)(r - (WINDOW - 1) + w) * IN_PAD + C_V + kv * HD + lane]) : 0.f; }
            else if (w < WINDOW - 1) vv = cv[((size_t)(w + 1) * KV_ATT + kv) * HD + lane];
            else vv = bf2f(Z[(size_t)r * IN_PAD + C_V + kv * HD + lane]);
            o += pw * vv;
        }
        O[(size_t)r * D + hh * HD + lane] = (bf16)f2bf(o);
    }
}

__device__ __forceinline__ void ph_resnorm(const Params& p, const float* gpost, const float* gnext) {
    const int tidx = tid_opaque();
    const float* OUTF = (const float*)(p.ws + WS_F1); bf16* XN = (bf16*)(p.ws + WS_XN);
    const int lane = tidx & 63, gw = (blockIdx.x * blockDim.x + tidx) >> 6, nw = (gridDim.x * blockDim.x) >> 6;
    for (int r = gw; r < R; r += nw) {
        f32x4 v[4], x[4]; float ss = 0.f;
#pragma unroll
        for (int j = 0; j < 4; ++j) { v[j] = *(const f32x4*)(OUTF + (size_t)r * D + lane * 4 + j * 256); ss += v[j].x * v[j].x + v[j].y * v[j].y + v[j].z * v[j].z + v[j].w * v[j].w; }
        const float rstd = rsqrtf(wave_sum(ss) * (1.f / D) + EPS);
        float s2 = 0.f;
#pragma unroll
        for (int j = 0; j < 4; ++j) { const f32x4 gg = *(const f32x4*)(gpost + lane * 4 + j * 256); float* xp = p.out + (size_t)r * D + lane * 4 + j * 256;
            x[j] = *(const f32x4*)xp + v[j] * rstd * gg; *(f32x4*)xp = x[j]; s2 += x[j].x * x[j].x + x[j].y * x[j].y + x[j].z * x[j].z + x[j].w * x[j].w; }
        if (gnext) {
            const float rstd2 = rsqrtf(wave_sum(s2) * (1.f / D) + EPS);
#pragma unroll
            for (int j = 0; j < 4; ++j) { const f32x4 gg = *(const f32x4*)(gnext + lane * 4 + j * 256);
                u32x2 w; w.x = pk2(x[j].x * rstd2 * gg.x, x[j].y * rstd2 * gg.y); w.y = pk2(x[j].z * rstd2 * gg.z, x[j].w * rstd2 * gg.w);
                *(u32x2*)(XN + (size_t)r * D + lane * 4 + j * 256) = w; }
        }
    }
}

__device__ __forceinline__ void ph_xattn_prompt(const Params& p) {
    const int tidx = tid_opaque();
    const bf16* Q2 = (const bf16*)(p.ws + WS_B1); const bf16* MK = (const bf16*)(p.ws + WS_MK); const bf16* MVt = (const bf16*)(p.ws + WS_MV); bf16* O2 = (bf16*)(p.ws + WS_B2);
    const int lane = tidx & 63, w = tidx >> 6, r32 = lane & 31, hk = lane >> 5;
    for (int unit = blockIdx.x; unit < BATCH * XH * 8; unit += gridDim.x) {
        const int b = unit >> 5, hh = (unit >> 3) & 3, qb = unit & 7;
        const size_t row = (size_t)b * SEQ + qb * 256 + w * 32 + r32;
        const bf16* qp = Q2 + row * D + hh * XHD + 8 * hk;
        bf16x8 qf[16];
#pragma unroll
        for (int ks = 0; ks < 16; ++ks) qf[ks] = *(const bf16x8*)(qp + 16 * ks);
        f32x16 S[8];
        const bf16* kbase = MK + ((size_t)b * MEM + kappa(r32)) * D + hh * XHD + 8 * hk;
#pragma unroll
        for (int kt = 0; kt < 8; ++kt) {
            f32x16 acc;
#pragma unroll
            for (int i = 0; i < 16; ++i) acc[i] = 0.f;
#pragma unroll
            for (int ks = 0; ks < 16; ++ks) { const bf16x8 kf = *(const bf16x8*)(kbase + (size_t)(32 * kt) * D + 16 * ks); acc = MFMA32(kf, qf[ks], acc); }
            S[kt] = acc;
        }
        float m = -INFINITY;
#pragma unroll
        for (int kt = 0; kt < 8; ++kt)
#pragma unroll
            for (int i = 0; i < 16; ++i) m = fmaxf(m, S[kt][i]);
        m = fmaxf(m, __shfl_xor(m, 32));
        const float sc = 0.0625f * 1.4426950408889634f;
        float sum = 0.f;
#pragma unroll
        for (int kt = 0; kt < 8; ++kt)
#pragma unroll
            for (int i = 0; i < 16; ++i) { const float e = __builtin_amdgcn_exp2f((S[kt][i] - m) * sc); S[kt][i] = e; sum += e; }
        sum += __shfl_xor(sum, 32);
        const float inv = 1.f / sum;
        bf16x8 pf[8][2];
#pragma unroll
        for (int kt = 0; kt < 8; ++kt) { pf[kt][0] = pack8(S[kt], 0); pf[kt][1] = pack8(S[kt], 1); }
        const bf16* vbase = MVt + ((size_t)(b * XH + hh) * XHD + r32) * MEM + 8 * hk;
        bf16* op = O2 + row * D + hh * XHD + 4 * hk;
#pragma unroll 1
        for (int dt = 0; dt < 8; ++dt) {
            f32x16 o;
#pragma unroll
            for (int i = 0; i < 16; ++i) o[i] = 0.f;
#pragma unroll
            for (int kt = 0; kt < 8; ++kt)
#pragma unroll
                for (int s = 0; s < 2; ++s) { const bf16x8 vf = *(const bf16x8*)(vbase + (size_t)(dt * 32) * MEM + 32 * kt + 16 * s); o = MFMA32(vf, pf[kt][s], o); }
#pragma unroll
            for (int g = 0; g < 4; ++g) { u32x2 wv; wv.x = cvtpk(o[4 * g] * inv, o[4 * g + 1] * inv); wv.y = cvtpk(o[4 * g + 2] * inv, o[4 * g + 3] * inv); *(u32x2*)(op + 32 * dt + 8 * g) = wv; }
        }
    }
}
__device__ __forceinline__ void ph_xattn_sample(const Params& p, const int l, LASP unsigned char* lds) {
    const int tidx = tid_opaque();
    const bf16* Q2 = (const bf16*)(p.ws + WS_B1); bf16* O2 = (bf16*)(p.ws + WS_B2);
    const int lane = tidx & 63, w = tidx >> 6;
    LASP float* scl = (LASP float*)lds; LASP float* part = (LASP float*)(lds + 1024);
    for (int unit = blockIdx.x; unit < DB * XH; unit += gridDim.x) {
        const int bb = unit >> 2, hh = unit & 3; const size_t r = RPROMPT + bb;
        float q[4]; { const u32x2 wq = *(const u32x2*)(Q2 + r * D + hh * XHD + lane * 4); q[0] = bf2f(wq.x & 0xffffu); q[1] = bf2f(wq.x >> 16); q[2] = bf2f(wq.y & 0xffffu); q[3] = bf2f(wq.y >> 16); }
        const float* ck = p.in[I_CMK] + (((size_t)l * DB + bb) * MEM + 32 * w) * XH * XHD + hh * XHD + lane * 4;
        const float* cv = p.in[I_CMV] + (((size_t)l * DB + bb) * MEM + 32 * w) * XH * XHD + hh * XHD + lane * 4;
        float mys = 0.f;
#pragma unroll
        for (int kb = 0; kb < 4; ++kb) { f32x4 kv[8];
#pragma unroll
            for (int i = 0; i < 8; ++i) kv[i] = *(const f32x4*)(ck + (size_t)(8 * kb + i) * XH * XHD);
#pragma unroll
            for (int i = 0; i < 8; ++i) { const float s = wave_sum(q[0] * kv[i].x + q[1] * kv[i].y + q[2] * kv[i].z + q[3] * kv[i].w) * 0.0625f; if (lane == 8 * kb + i) mys = s; } }
        if (lane < 32) scl[32 * w + lane] = mys;
        __syncthreads();
        const float v0 = scl[lane], v1 = scl[lane + 64], v2 = scl[lane + 128], v3 = scl[lane + 192];
        const float m = wave_max(fmaxf(fmaxf(v0, v1), fmaxf(v2, v3)));
        const float sum = wave_sum(__expf(v0 - m) + __expf(v1 - m) + __expf(v2 - m) + __expf(v3 - m));
        const float pme = __expf(mys - m) / sum;
        float o[4] = {0.f, 0.f, 0.f, 0.f};
#pragma unroll
        for (int kb = 0; kb < 4; ++kb) { f32x4 vv[8];
#pragma unroll
            for (int i = 0; i < 8; ++i) vv[i] = *(const f32x4*)(cv + (size_t)(8 * kb + i) * XH * XHD);
#pragma unroll
            for (int i = 0; i < 8; ++i) { const float pk = __shfl(pme, 8 * kb + i); o[0] += pk * vv[i].x; o[1] += pk * vv[i].y; o[2] += pk * vv[i].z; o[3] += pk * vv[i].w; } }
        *(LASP f32x4*)(part + w * 256 + lane * 4) = (f32x4){o[0], o[1], o[2], o[3]};
        __syncthreads();
        if (w == 0) { f32x4 t = *(LASP f32x4*)(part + lane * 4);
#pragma unroll
            for (int j = 1; j < 8; ++j) t += *(LASP f32x4*)(part + j * 256 + lane * 4);
            u32x2 wv; wv.x = pk2(t.x, t.y); wv.y = pk2(t.z, t.w); *(u32x2*)(O2 + r * D + hh * XHD + lane * 4) = wv; }
        __syncthreads();
    }
}

__device__ __forceinline__ void ph_ffnconv(const Params& p, const int l) {
    const int tidx = tid_opaque();
    const bf16* AG = (const bf16*)(p.ws + WS_AG); bf16* HID = (bf16*)(p.ws + WS_HID);
    const float* cw = p.in[I_FCW] + (size_t)l * 3 * DFF; const float* cb = p.in[I_FCB] + (size_t)l * DFF;
    const int nitems = R * (DFF / 8);
    for (int it = blockIdx.x * blockDim.x + tidx; it < nitems; it += gridDim.x * blockDim.x) {
        const int r = it / (DFF / 8), c0 = (it % (DFF / 8)) * 8;
        float x[3][8], g[8], c[8], acc[8];
        const bf16* ar = AG + (size_t)r * 2 * DFF + c0;
        ld8(ar, x[2]); ld8(ar + DFF, g);
        if (r < RPROMPT) {
            const int t = r & (SEQ - 1);
#pragma unroll
            for (int k = 0; k < 2; ++k) {
                if (t - 2 + k >= 0) ld8(ar - (size_t)(2 - k) * 2 * DFF, x[k]);
                else {
#pragma unroll
                    for (int i = 0; i < 8; ++i) x[k][i] = 0.f; }
            }
            if (t >= SEQ - 2) st8f(p.out + O_PFC + (((size_t)l * BATCH + (r >> 11)) * 2 + (t - (SEQ - 2))) * DFF + c0, x[2]);
        } else {
            const int bb = r - RPROMPT; const float* buf = p.in[I_SFC] + ((size_t)l * DB + bb) * 2 * DFF;
            ld8f(buf + c0, x[0]); ld8f(buf + DFF + c0, x[1]);
            float* so = p.out + O_SFC + ((size_t)l * DB + bb) * 2 * DFF;
            st8f(so + c0, x[1]); st8f(so + DFF + c0, x[2]);
        }
        ld8f(cb + c0, acc);
#pragma unroll
        for (int k = 0; k < 3; ++k) { ld8f(cw + (size_t)k * DFF + c0, c);
#pragma unroll
            for (int i = 0; i < 8; ++i) acc[i] += c[i] * x[k][i]; }
#pragma unroll
        for (int i = 0; i < 8; ++i) acc[i] = siluf_(acc[i]) * g[i];
        st8(HID + (size_t)r * DFF + c0, acc);
    }
}


namespace pg8 {
#define PG8_LAS __attribute__((address_space(3)))
typedef unsigned short bf16_t;
typedef short bf16x8 __attribute__((ext_vector_type(8)));
typedef float f32x4 __attribute__((ext_vector_type(4)));
typedef unsigned u32x4 __attribute__((ext_vector_type(4)));
constexpr int BM = 256, BK = 64, HALF = 128, HTB = HALF * BK * 2  , STAGE_BYTES = 8 * HTB, NXCD = 8, WGM = 8;

__host__ __device__ __forceinline__ int lds_byte(int r, int c) { const int st = (r >> 4) * 2 + (c >> 5), rr = r & 15, cc = c & 31, ob = rr * 64 + cc * 2; return st * 1024 + (ob ^ (((ob >> 9) & 1) << 5)); }
__host__ __device__ __forceinline__ void stage_rc(int b, int& R, int& C) { const int st = b / 1024, sb = b % 1024, swz = sb ^ (((sb >> 9) & 1) << 5); R = (st >> 1) * 16 + swz / 64; C = (st & 1) * 32 + (swz % 64) / 2; }
__host__ __device__ __forceinline__ int perm32(int rho) { const int n = rho >> 4, i = rho & 15; return 8 * (i >> 2) + 4 * n + (i & 3); }

struct Unit { int pm, pn; };
struct Gemm { const bf16_t* A; const bf16_t* Bt; int M, N, K; };

struct StaticOrder {
    int nM, nN, nwg, G, c;
    __host__ __device__ void init(int M, int N, int G_, int c_) { nM = M / BM; nN = N / BM; nwg = nM * nN; G = G_; c = c_; }
    __host__ __device__ bool next(int i, Unit& u) const {
        const long L = (long)i * G + c; if (L >= nwg) return false;
        int wgid = (int)L; { const int q = nwg / NXCD, r = nwg % NXCD, xcd = wgid % NXCD, off = wgid / NXCD; wgid = (xcd < r ? xcd * (q + 1) : r * (q + 1) + (xcd - r) * q) + off; }
        const int nig = WGM * nN, gid = wgid / nig, fm = gid * WGM, gsz = (nM - fm) < WGM ? (nM - fm) : WGM;
        u.pm = fm + ((wgid % nig) % gsz); u.pn = (wgid % nig) / gsz; return true;
    }
    __device__ __forceinline__ void a_ready(const Unit&) const {}
    __device__ __forceinline__ void done(const Unit&) const {}
};

__device__ __forceinline__ unsigned cvt_pk_bf16(float lo, float hi) { unsigned r; asm volatile("v_cvt_pk_bf16_f32 %0, %1, %2" : "=v"(r) : "v"(lo), "v"(hi)); return r; }
template <class F> struct EpiAdapt {
    static constexpr bool PERM = false, AFTER_DRAIN = false; F f;
    __device__ __forceinline__ void operator()(const f32x4 (&acc)[2][2][4][2], const Unit& u, int wr, int wc, int fr, int fq) const {
#pragma unroll
        for (int ai = 0; ai < 2; ++ai)
#pragma unroll
            for (int m = 0; m < 4; ++m) { const int row = u.pm * BM + ai * HALF + wr * 64 + m * 16 + fr;
#pragma unroll
                for (int bj = 0; bj < 2; ++bj)
#pragma unroll
                    for (int n = 0; n < 2; ++n) f(row, u.pn * BM + bj * HALF + wc * 32 + n * 16 + fq * 4, acc[ai][bj][m][n]); }
    }
};
template <class Epi, class Sched, bool ALIGN_EPI = false, bool SP2 = false>
__device__ __forceinline__ void gemm_phase(PG8_LAS unsigned char* lds, const Gemm g, const Sched& S, const Epi& E) {
    int tid_ = threadIdx.x; asm volatile("" : "+v"(tid_));
    const int tid = tid_, wid = __builtin_amdgcn_readfirstlane(tid >> 6), lane = tid & 63, wr = wid >> 2, wc = wid & 3, fr = lane & 15, fq = lane >> 4;
    const int K = g.K, nt = K / BK;
    unsigned voffA[2], voffB[2];
#pragma unroll
    for (int i = 0; i < 2; ++i) { int R, C; stage_rc(tid * 16 + i * 8192, R, C); const int Rb = Epi::PERM ? ((R & ~31) + perm32(R & 31)) : R;
        voffA[i] = (unsigned)(R * K + C) * 2u; voffB[i] = (unsigned)(Rb * K + C) * 2u; }
    const size_t kstep = (size_t)(BK * 2);
    const size_t hstep = (size_t)HALF * K * 2;
    const size_t tstep = 2 * hstep;
    const unsigned ldsw = (unsigned)wid * 1024u;
    const int aoff = lds_byte(wr * 64 + fr, fq * 8), boff = lds_byte(wc * 32 + fr, fq * 8);
#define PG8_SA(b, h) (((b) * 2 + (h)) * HTB)
#define PG8_SB(b, h) ((4 + (b) * 2 + (h)) * HTB)
#define PG8_STAGE(bufoff, gbase, voff) do { _Pragma("unroll") for (int _i = 0; _i < 2; ++_i) \
        __builtin_amdgcn_global_load_lds((const unsigned*)((const char*)(gbase) + (voff)[_i]), (PG8_LAS unsigned*)(lds + (bufoff) + ldsw + _i * 8192), 16, 0, 0); } while (0)
#define PG8_LDA(dst, b, h) do { _Pragma("unroll") for (int m = 0; m < 4; ++m) _Pragma("unroll") for (int k = 0; k < 2; ++k) dst[m][k] = *(const PG8_LAS bf16x8*)(lds + PG8_SA(b, h) + aoff + m * 2048 + k * 1024); } while (0)
#define PG8_LDB(dst, b, h) do { _Pragma("unroll") for (int n = 0; n < 2; ++n) _Pragma("unroll") for (int k = 0; k < 2; ++k) dst[n][k] = *(const PG8_LAS bf16x8*)(lds + PG8_SB(b, h) + boff + n * 2048 + k * 1024); } while (0)
#define PG8_MMA(ai, bj, At, Bt) do { __builtin_amdgcn_s_setprio(1); _Pragma("unroll") for (int m = 0; m < 4; ++m) _Pragma("unroll") for (int n = 0; n < 2; ++n) _Pragma("unroll") for (int k = 0; k < 2; ++k) \
        acc[ai][bj][m][n] = __builtin_amdgcn_mfma_f32_16x16x32_bf16(Bt[n][k], At[m][k], acc[ai][bj][m][n], 0, 0, 0); __builtin_amdgcn_s_setprio(0); } while (0)
#define PG8_WAIT_V(n) asm volatile("s_waitcnt vmcnt(" #n ")" ::: "memory")
#define PG8_WAIT_L(n) asm volatile("s_waitcnt lgkmcnt(" #n ")" ::: "memory")
#define PG8_BAR __builtin_amdgcn_s_barrier()
#define PG8_SCHED __builtin_amdgcn_sched_barrier(0)
    Unit cur, nxt; int ui = 0;
    if (!S.next(0, cur)) return;
    f32x4 acc[2][2][4][2];
#pragma unroll
    for (int a = 0; a < 2; ++a)
#pragma unroll
        for (int b = 0; b < 2; ++b)
#pragma unroll
            for (int m = 0; m < 4; ++m)
#pragma unroll
                for (int n = 0; n < 2; ++n) acc[a][b][m][n] = (f32x4){0.f, 0.f, 0.f, 0.f};
    bf16x8 At[4][2], B0[2][2], B1[2][2];
    const char* cA = (const char*)g.A + (size_t)cur.pm * tstep; const char* cB = (const char*)g.Bt + (size_t)cur.pn * tstep;
    S.a_ready(cur);
    if constexpr (SP2) {
        PG8_STAGE(PG8_SB(0, 0), cB, voffB); PG8_STAGE(PG8_SB(0, 1), cB + hstep, voffB); PG8_STAGE(PG8_SA(0, 0), cA, voffA); PG8_STAGE(PG8_SA(0, 1), cA + hstep, voffA);
        if (wr == 1) PG8_BAR;
        PG8_WAIT_V(2); PG8_BAR;
        PG8_STAGE(PG8_SB(1, 0), cB + kstep, voffB); PG8_STAGE(PG8_SA(1, 0), cA + kstep, voffA); PG8_STAGE(PG8_SB(1, 1), cB + hstep + kstep, voffB);
        PG8_WAIT_V(6); PG8_BAR;
    } else {
        PG8_STAGE(PG8_SB(0, 0), cB, voffB); PG8_STAGE(PG8_SA(0, 0), cA, voffA); PG8_STAGE(PG8_SB(0, 1), cB + hstep, voffB); PG8_STAGE(PG8_SA(0, 1), cA + hstep, voffA);
        if (wr == 1) PG8_BAR;
        PG8_WAIT_V(4); PG8_BAR;
        PG8_STAGE(PG8_SB(1, 0), cB + kstep, voffB); PG8_STAGE(PG8_SA(1, 0), cA + kstep, voffA); PG8_STAGE(PG8_SB(1, 1), cB + hstep + kstep, voffB);
        PG8_WAIT_V(6); PG8_BAR;
    }
    for (;;) {
        const bool has_next = S.next(ui + 1, nxt);
        const char* nA = has_next ? (const char*)g.A + (size_t)nxt.pm * tstep : cA; const char* nB = has_next ? (const char*)g.Bt + (size_t)nxt.pn * tstep : cB;
        for (int t = 0; t < nt; t += 2) {
            const bool last = (t == nt - 2);
            const char* a1 = cA + (size_t)(t + 1) * kstep;
            const char* a2 = last ? nA : cA + (size_t)(t + 2) * kstep; const char* b2 = last ? nB : cB + (size_t)(t + 2) * kstep;
            const char* a3 = a2 + kstep; const char* b3 = b2 + kstep;
            if (last && has_next) S.a_ready(nxt);
            if constexpr (SP2) {
            PG8_LDB(B0, 0, 0); PG8_LDB(B1, 0, 1); PG8_SCHED; PG8_LDA(At, 0, 0); PG8_STAGE(PG8_SA(1, 1), a1 + hstep, voffA);
            PG8_WAIT_V(8); PG8_WAIT_L(0); PG8_BAR; PG8_MMA(0, 0, At, B0); PG8_MMA(0, 1, At, B1); PG8_BAR; PG8_SCHED;
            PG8_LDA(At, 0, 1); PG8_STAGE(PG8_SB(0, 0), b2, voffB); PG8_STAGE(PG8_SB(0, 1), b2 + hstep, voffB); PG8_STAGE(PG8_SA(0, 0), a2, voffA);
            PG8_WAIT_V(8); PG8_WAIT_L(0); PG8_BAR; PG8_MMA(1, 0, At, B0); PG8_MMA(1, 1, At, B1); PG8_BAR; PG8_SCHED;
            PG8_LDB(B0, 1, 0); PG8_LDB(B1, 1, 1); PG8_SCHED; PG8_LDA(At, 1, 0); PG8_STAGE(PG8_SA(0, 1), a2 + hstep, voffA);
            PG8_WAIT_V(8); PG8_WAIT_L(0); PG8_BAR; PG8_MMA(0, 0, At, B0); PG8_MMA(0, 1, At, B1); PG8_BAR; PG8_SCHED;
            PG8_LDA(At, 1, 1); PG8_STAGE(PG8_SB(1, 0), b3, voffB); PG8_STAGE(PG8_SB(1, 1), b3 + hstep, voffB); PG8_STAGE(PG8_SA(1, 0), a3, voffA);
            PG8_WAIT_V(8); PG8_WAIT_L(0); PG8_BAR; PG8_MMA(1, 0, At, B0); PG8_MMA(1, 1, At, B1); PG8_BAR; PG8_SCHED;
            } else {
            PG8_LDB(B0, 0, 0); PG8_SCHED; PG8_LDA(At, 0, 0); PG8_STAGE(PG8_SA(1, 1), a1 + hstep, voffA);
            PG8_WAIT_L(8); PG8_BAR; PG8_WAIT_L(0); PG8_MMA(0, 0, At, B0); PG8_BAR; PG8_SCHED;
            PG8_LDB(B1, 0, 1); PG8_STAGE(PG8_SB(0, 0), b2, voffB);
            PG8_BAR; PG8_WAIT_L(0); PG8_MMA(0, 1, At, B1); PG8_BAR;
            PG8_LDA(At, 0, 1); PG8_STAGE(PG8_SA(0, 0), a2, voffA);
            PG8_BAR; PG8_WAIT_L(0); PG8_MMA(1, 0, At, B0); PG8_BAR; PG8_SCHED;
            PG8_STAGE(PG8_SB(0, 1), b2 + hstep, voffB);
            PG8_WAIT_V(6); PG8_BAR; PG8_MMA(1, 1, At, B1); PG8_BAR;
            PG8_LDB(B0, 1, 0); PG8_SCHED; PG8_LDA(At, 1, 0); PG8_STAGE(PG8_SA(0, 1), a2 + hstep, voffA);
            PG8_WAIT_L(8); PG8_BAR; PG8_WAIT_L(0); PG8_MMA(0, 0, At, B0); PG8_BAR; PG8_SCHED;
            PG8_LDB(B1, 1, 1); PG8_STAGE(PG8_SB(1, 0), b3, voffB);
            PG8_BAR; PG8_WAIT_L(0); PG8_MMA(0, 1, At, B1); PG8_BAR;
            PG8_LDA(At, 1, 1); PG8_STAGE(PG8_SA(1, 0), a3, voffA);
            PG8_BAR; PG8_WAIT_L(0); PG8_MMA(1, 0, At, B0); PG8_BAR; PG8_SCHED;
            PG8_STAGE(PG8_SB(1, 1), b3 + hstep, voffB);
            PG8_WAIT_V(6); PG8_BAR; PG8_MMA(1, 1, At, B1); PG8_BAR;
            }
        }
        if constexpr (ALIGN_EPI) { if (wr == 0) PG8_BAR; }
        if constexpr (!Epi::AFTER_DRAIN) { E(acc, cur, wr, wc, fr, fq); S.done(cur); }
        if (!has_next) break;
#pragma unroll
        for (int a = 0; a < 2; ++a)
#pragma unroll
            for (int b = 0; b < 2; ++b)
#pragma unroll
                for (int m = 0; m < 4; ++m)
#pragma unroll
                    for (int n = 0; n < 2; ++n) acc[a][b][m][n] = (f32x4){0.f, 0.f, 0.f, 0.f};
        cur = nxt; cA = nA; cB = nB; ++ui;
        if constexpr (ALIGN_EPI) { if (wr == 1) PG8_BAR; }
    }
    PG8_WAIT_V(0);
    if constexpr (!ALIGN_EPI) { if (wr == 0) PG8_BAR; }
    PG8_BAR;
    if constexpr (Epi::AFTER_DRAIN) { E.fused(acc, cur, wr, wc, fr, fq, lds, wid, lane); S.done(cur); }
#undef PG8_SA
#undef PG8_SB
#undef PG8_STAGE
#undef PG8_LDA
#undef PG8_LDB
#undef PG8_MMA
#undef PG8_WAIT_V
#undef PG8_WAIT_L
#undef PG8_BAR
#undef PG8_SCHED
}
}

#define GAS __attribute__((address_space(1)))
#define LAS __attribute__((address_space(3)))
typedef GAS unsigned gu32;
#define RLX_AGENT __ATOMIC_RELAXED, __HIP_MEMORY_SCOPE_AGENT
#define LDS_WAIT() asm volatile("s_waitcnt lgkmcnt(0)" ::: "memory")
constexpr int NT = 512, NWAVES = 8;
constexpr int RING_OFF = 0, RING_BYTES = 131072;
constexpr int LDSCTL_OFF = RING_BYTES, MISC_OFF = LDSCTL_OFF + 320;
constexpr int LDS_BYTES = 147456;
constexpr int CW_BAR = 4096;
constexpr size_t CTL_ZERO_BYTES = 1 * MiB;
#define XB_TMO      128
#define XB_XCNT(j)  (256  + 64 * (j))
#define XB_XSUB(j)  (1280 + 64 * (j))
#define XB_XGEN(j)  (2304 + 64 * (j))
#define XB_TOP      3328
#define XB_TOPGEN   3392
#define XCD_BAR_WORDS 3456
#define XB_SPIN_CAP (1u << 18)

__device__ __forceinline__ unsigned xb_ld(unsigned* p)              { return __hip_atomic_load(p, __ATOMIC_RELAXED, __HIP_MEMORY_SCOPE_AGENT); }
__device__ __forceinline__ unsigned xb_add(unsigned* p, unsigned v) { return __hip_atomic_fetch_add(p, v, __ATOMIC_RELAXED, __HIP_MEMORY_SCOPE_AGENT); }
__device__ __forceinline__ unsigned xb_xcc_id() { return (unsigned)__builtin_amdgcn_s_getreg((3 << 11) | 20) & 0xFu; }
#define XB_SPIN(cond, bar) do { unsigned _sp = 0; while (cond) { __builtin_amdgcn_s_sleep(1); \
    if ((++_sp & 255u) == 0u) { if (xb_ld(&(bar)[XB_TMO])) break; if (_sp > XB_SPIN_CAP) { atomicAdd(&(bar)[XB_TMO], 1u); break; } } } } while (0)

struct XcdBarrier {
    unsigned* bar; unsigned x;
    volatile LAS unsigned* st;
};

__device__ __forceinline__ XcdBarrier xcd_barrier_post(unsigned* bar, volatile LAS unsigned* st) {
    XcdBarrier b; b.bar = bar; b.x = xb_xcc_id(); b.st = st;
    if (threadIdx.x == 0) (void)xb_add(&bar[XB_XCNT(b.x)], 1u);
    return b;
}
__device__ __forceinline__ void xcd_barrier_complete(unsigned* bar, unsigned x, unsigned& nloc, unsigned& nx) {
    const unsigned G = gridDim.x * gridDim.y * gridDim.z;
    unsigned sum, cnt, mine, sp = 0u;
    for (;;) {
        sum = 0u; cnt = 0u; mine = 0u;
#pragma unroll
        for (unsigned j = 0; j < 16; ++j) { const unsigned c = xb_ld(&bar[XB_XCNT(j)]); sum += c; cnt += (c > 0u) ? 1u : 0u; mine = (j == x) ? c : mine; }
        if (sum == G) break;
        __builtin_amdgcn_s_sleep(1);
        if ((++sp & 255u) == 0u) { if (xb_ld(&bar[XB_TMO])) break; if (sp > XB_SPIN_CAP) { atomicAdd(&bar[XB_TMO], 1u); break; } }
    }
    nloc = mine > 0u ? mine : 1u; nx = cnt > 0u ? cnt : 1u;
}

__device__ __forceinline__ void xcd_barrier(const XcdBarrier& b) {
    asm volatile("s_waitcnt vmcnt(0)" ::: "memory");
    __syncthreads();
    if (threadIdx.x == 0) {
        unsigned* bar = b.bar;
        __builtin_amdgcn_s_waitcnt(0);
        unsigned nloc = b.st[0], nx = b.st[1];
        if (nloc == 0u) { xcd_barrier_complete(bar, b.x, nloc, nx); b.st[0] = nloc; b.st[1] = nx; }
        const unsigned old = xb_add(&bar[XB_XSUB(b.x)], 1u);
        const unsigned gen = old / nloc;
        if (old + 1u == (gen + 1u) * nloc) {
            __builtin_amdgcn_fence(__ATOMIC_RELEASE, "agent");
            asm volatile("s_waitcnt vmcnt(0)" ::: "memory");
            const unsigned og = xb_add(&bar[XB_TOP], 1u);
            const unsigned tg = og / nx;
            if (og + 1u == (tg + 1u) * nx) xb_add(&bar[XB_TOPGEN], 1u);
            else XB_SPIN(xb_ld(&bar[XB_TOPGEN]) == tg, bar);
            __builtin_amdgcn_fence(__ATOMIC_ACQUIRE, "agent");
            xb_add(&bar[XB_XGEN(b.x)], 1u);
            asm volatile("s_waitcnt vmcnt(0)" ::: "memory");
        } else {
            XB_SPIN(xb_ld(&bar[XB_XGEN(b.x)]) == gen, bar);
            __builtin_amdgcn_fence(__ATOMIC_ACQUIRE, "agent");
            asm volatile("s_waitcnt vmcnt(0)" ::: "memory");
        }
    }
    __syncthreads();
}

__device__ __forceinline__ void p0_transpose_item(const float* W, int K, int N, bf16* WT, int row_off, LAS float* scr, int item, int lane) {
    const int nblk = N / 32, kb = item / nblk, nb = item % nblk, k0 = 64 * kb, n0 = 32 * nb;
#pragma unroll 8
    for (int i = 0; i < 32; ++i) { const int kk = 2 * i + (lane >> 5); scr[kk * 33 + (lane & 31)] = W[(size_t)(k0 + kk) * N + n0 + (lane & 31)]; }
    LDS_WAIT(); asm volatile("" ::: "memory");
    const int c = lane & 7;
#pragma unroll
    for (int j = 0; j < 4; ++j) { const int n = (lane >> 3) + 8 * j; const LAS float* s = scr + (8 * c) * 33 + n;
        u32x4 o; o.x = pk2(s[0 * 33], s[1 * 33]); o.y = pk2(s[2 * 33], s[3 * 33]); o.z = pk2(s[4 * 33], s[5 * 33]); o.w = pk2(s[6 * 33], s[7 * 33]);
        *(u32x4*)(WT + (size_t)(row_off + n0 + n) * K + k0 + 8 * c) = o; }
    LDS_WAIT(); asm volatile("" ::: "memory");
}
__device__ __forceinline__ void wconv_mat(const float* W, int K, int N, bf16* WT, int row_off, LAS float* scr, int gw, int ngw, int lane) {
    const int nitems = (K / 64) * (N / 32);
    for (int item = gw; item < nitems; item += ngw) p0_transpose_item(W, K, N, WT, row_off, scr, item, lane);
}
__device__ __forceinline__ void ph_prologue(const Params& p, LAS unsigned char* lds) {
    const int tid = threadIdx.x, lane = tid & 63, wave = tid >> 6;
    LAS float* scr = (LAS float*)(lds + RING_OFF + wave * 16384);
    const int gw = blockIdx.x * NWAVES + wave, ngw = gridDim.x * NWAVES;
    for (int l = 0; l < DEPTH; ++l) {
        unsigned char* wl = p.ws + WS_W + l * W_LAYER;
        wconv_mat(p.in[I_WIN] + (size_t)l * D * IN_DIM, D, IN_DIM, (bf16*)(wl + W_IN), 0, scr, gw, ngw, lane);
        wconv_mat(p.in[I_WAO] + (size_t)l * D * D, D, D, (bf16*)(wl + W_A), 0, scr, gw, ngw, lane);
        wconv_mat(p.in[I_WSO] + (size_t)l * DSSM * D, DSSM, D, (bf16*)(wl + W_SSM), 0, scr, gw, ngw, lane);
        wconv_mat(p.in[I_WATT] + (size_t)l * D * D, D, D, (bf16*)(wl + W_ATT), 0, scr, gw, ngw, lane);
        wconv_mat(p.in[I_WOUT] + (size_t)l * D * D, D, D, (bf16*)(wl + W_OUT), 0, scr, gw, ngw, lane);
        wconv_mat(p.in[I_WXQ] + (size_t)l * D * D, D, D, (bf16*)(wl + W_XQ), 0, scr, gw, ngw, lane);
        wconv_mat(p.in[I_WXK] + (size_t)l * D * D, D, D, (bf16*)(wl + W_XKV), 0, scr, gw, ngw, lane);
        wconv_mat(p.in[I_WXV] + (size_t)l * D * D, D, D, (bf16*)(wl + W_XKV), D, scr, gw, ngw, lane);
        wconv_mat(p.in[I_WXO] + (size_t)l * D * D, D, D, (bf16*)(wl + W_XO), 0, scr, gw, ngw, lane);
        wconv_mat(p.in[I_WFI] + (size_t)l * D * 2 * DFF, D, 2 * DFF, (bf16*)(wl + W_FFI), 0, scr, gw, ngw, lane);
        wconv_mat(p.in[I_WFO] + (size_t)l * DFF * D, DFF, D, (bf16*)(wl + W_FFO), 0, scr, gw, ngw, lane);
        u32x4* pad = (u32x4*)(wl + W_IN + (size_t)IN_DIM * D * 2); const int npad = (IN_PAD - IN_DIM) * D * 2 / 16;
        for (int i = blockIdx.x * NT + tid; i < npad; i += gridDim.x * NT) pad[i] = (u32x4){0u, 0u, 0u, 0u};
    }
    { u32x4* pad = (u32x4*)(p.ws + WS_XN + (size_t)R * D * 2); const int npad = (RPAD - R) * D * 2 / 16;
      for (int i = blockIdx.x * NT + tid; i < npad; i += gridDim.x * NT) pad[i] = (u32x4){0u, 0u, 0u, 0u}; }
    ph_xinit(p);
    ph_normrows(p.in[I_MEM], BATCH * MEM, p.in[I_NMEM], (bf16*)(p.ws + WS_MN));
}

#ifndef MK_PER_PHASE
#define MK_PER_PHASE 0
#endif
constexpr int NPH = 15, N_PHASES = 1 + DEPTH * NPH;
struct Args { Params p; long ph_lo, ph_hi; };

template <class F> __device__ __forceinline__ void run_gemm(LAS unsigned char* lds, const bf16* A, const bf16* Bt, int M, int N, int K, const F& f) {
    pg8::Gemm g{A, Bt, M, N, K}; pg8::StaticOrder S; S.init(M, N, (int)gridDim.x, (int)blockIdx.x);
    pg8::EpiAdapt<F> E{f};
    pg8::gemm_phase<pg8::EpiAdapt<F>, pg8::StaticOrder, true, true>(lds + RING_OFF, g, S, E);
}

__global__ void __launch_bounds__(NT, 2) mega_fwd(Args args) {
    extern __shared__ __attribute__((aligned(16))) unsigned char lds_raw[];
    LAS unsigned char* lds = (LAS unsigned char*)lds_raw;
    volatile LAS unsigned* MISC = (volatile LAS unsigned*)(lds + MISC_OFF);
    const Params& p = args.p;
    for (int u = threadIdx.x; u < (LDS_BYTES - LDSCTL_OFF) / 4; u += NT) ((LAS unsigned*)(lds + LDSCTL_OFF))[u] = 0u;
    __syncthreads();
    unsigned* ctl = (unsigned*)(p.ws + WS_CTL);
    XcdBarrier bar; bar.bar = ctl + CW_BAR; bar.x = 0; bar.st = nullptr;
    if (!MK_PER_PHASE) bar = xcd_barrier_post(ctl + CW_BAR, MISC + 8);
    const int lo = (int)args.ph_lo, hi = (int)args.ph_hi;
#define IN(k) (lo <= (k) && (k) < hi)
#define SEAM(k) do { if (!MK_PER_PHASE && IN(k) && IN((k) + 1)) xcd_barrier(bar); } while (0)
    unsigned char* ws = p.ws;
    bf16 *Z = (bf16*)(ws + WS_Z), *YG = (bf16*)(ws + WS_YG), *XN = (bf16*)(ws + WS_XN), *B1 = (bf16*)(ws + WS_B1), *B2 = (bf16*)(ws + WS_B2), *B3 = (bf16*)(ws + WS_B3), *B4 = (bf16*)(ws + WS_B4);
    bf16 *AG = (bf16*)(ws + WS_AG), *HID = (bf16*)(ws + WS_HID), *MN = (bf16*)(ws + WS_MN), *MK = (bf16*)(ws + WS_MK), *MVt = (bf16*)(ws + WS_MV);
    float *F0 = (float*)(ws + WS_F0), *F1 = (float*)(ws + WS_F1);

    if (IN(0)) ph_prologue(p, lds);
    SEAM(0);
    for (int l = 0; l < DEPTH; ++l) {
        const int b = 1 + l * NPH;
        const unsigned char* wl = ws + WS_W + (size_t)l * W_LAYER;
        if (IN(b + 0)) {
            run_gemm(lds, XN, (const bf16*)(wl + W_IN), RPAD, IN_PAD, D, EpiStoreBf16{Z, IN_PAD});
            run_gemm(lds, MN, (const bf16*)(wl + W_XKV), BATCH * MEM, 2 * D, D, EpiMemKV{p.out + O_PMK + (size_t)l * BATCH * MEM * D, p.out + O_PMV + (size_t)l * BATCH * MEM * D, MK, MVt});
        }
        SEAM(b + 0);
        if (IN(b + 1)) { ph_mixa(p, l); ph_ssmconv(p, l); ph_dt(p, l); ph_rope(p, l); ph_swashift(p, l); }
        SEAM(b + 1);
        if (IN(b + 2)) { ph_ssd_prompt(p, l, lds + RING_OFF); ph_ssd(p, l); ph_swa_prompt(p, l); ph_swa(p, l); }
        SEAM(b + 2);
        if (IN(b + 3)) ph_normyg(p, l);
        SEAM(b + 3);
        if (IN(b + 4)) {
            run_gemm(lds, B1, (const bf16*)(wl + W_A), RPAD, D, D, EpiGate<0>{Z, F0, B4});
            run_gemm(lds, YG, (const bf16*)(wl + W_SSM), RPAD, D, DSSM, EpiGate<1>{Z, F0, B4});
            run_gemm(lds, B3, (const bf16*)(wl + W_ATT), RPAD, D, D, EpiGate<2>{Z, F0, B4});
        }
        SEAM(b + 4);
        if (IN(b + 5)) run_gemm(lds, B4, (const bf16*)(wl + W_OUT), RPAD, D, D, EpiStoreF32{F1, D});
        SEAM(b + 5);
        if (IN(b + 6)) ph_resnorm(p, p.in[I_NMPOST] + (size_t)l * D, p.in[I_NXPRE] + (size_t)l * D);
        SEAM(b + 6);
        if (IN(b + 7)) run_gemm(lds, XN, (const bf16*)(wl + W_XQ), RPAD, D, D, EpiStoreBf16{B1, D});
        SEAM(b + 7);
        if (IN(b + 8)) { ph_xattn_prompt(p); ph_xattn_sample(p, l, lds + RING_OFF); }
        SEAM(b + 8);
        if (IN(b + 9)) run_gemm(lds, B2, (const bf16*)(wl + W_XO), RPAD, D, D, EpiStoreF32{F1, D});
        SEAM(b + 9);
        if (IN(b + 10)) ph_resnorm(p, p.in[I_NXPOST] + (size_t)l * D, p.in[I_NFPRE] + (size_t)l * D);
        SEAM(b + 10);
        if (IN(b + 11)) run_gemm(lds, XN, (const bf16*)(wl + W_FFI), RPAD, 2 * DFF, D, EpiStoreBf16{AG, 2 * DFF});
        SEAM(b + 11);
        if (IN(b + 12)) ph_ffnconv(p, l);
        SEAM(b + 12);
        if (IN(b + 13)) run_gemm(lds, HID, (const bf16*)(wl + W_FFO), RPAD, D, DFF, EpiStoreF32{F1, D});
        SEAM(b + 13);
        if (IN(b + 14)) {
            ph_resnorm(p, p.in[I_NFPOST] + (size_t)l * D, l + 1 < DEPTH ? p.in[I_NMPRE] + (size_t)(l + 1) * D : nullptr);
            if (l + 1 < DEPTH) ph_normrows(p.in[I_MEM], BATCH * MEM, p.in[I_NMEM] + (size_t)(l + 1) * D, MN);
        }
        SEAM(b + 14);
    }
#undef IN
#undef SEAM
}

extern "C" void kernel_launch(void* const* d_in, const int* in_sizes, int n_in, void* d_out, int out_size, void* d_ws, size_t ws_size, hipStream_t stream) {
    static int grid = 0;
    if (grid == 0) {
        if (n_in != N_IN || (size_t)out_size != O_END || ws_size < WS_END) { fprintf(stderr, "kernel_launch: unexpected shapes (n_in %d out %d ws %zu)\n", n_in, out_size, ws_size); grid = -1; return; }
        int dev = 0, cus = 0, per_cu = 0;
        if (hipGetDevice(&dev) != hipSuccess || hipDeviceGetAttribute(&cus, hipDeviceAttributeMultiprocessorCount, dev) != hipSuccess) { grid = -1; return; }
        if (hipFuncSetAttribute((const void*)mega_fwd, hipFuncAttributeMaxDynamicSharedMemorySize, LDS_BYTES) != hipSuccess) { fprintf(stderr, "kernel_launch: hipFuncSetAttribute failed\n"); grid = -1; return; }
        if (hipOccupancyMaxActiveBlocksPerMultiprocessor(&per_cu, (const void*)mega_fwd, NT, LDS_BYTES) != hipSuccess || per_cu < 1) fprintf(stderr, "kernel_launch: occupancy query says %d\n", per_cu);
        (void)hipGetLastError();
        grid = cus;
    }
    if (grid < 0) return;
    if (hipMemsetAsync((char*)d_ws + WS_CTL, 0, CTL_ZERO_BYTES, stream) != hipSuccess) return;
    Args a{};
    for (int i = 0; i < N_IN; ++i) a.p.in[i] = (const float*)d_in[i];
    a.p.out = (float*)d_out; a.p.ws = (unsigned char*)d_ws;
#if MK_PER_PHASE
    for (int ph = 0; ph < N_PHASES; ++ph) { a.ph_lo = ph; a.ph_hi = ph + 1; hipLaunchKernelGGL(mega_fwd, dim3(grid), dim3(NT), LDS_BYTES, stream, a); }
#else
    a.ph_lo = 0; a.ph_hi = N_PHASES;
    hipLaunchKernelGGL(mega_fwd, dim3(grid), dim3(NT), LDS_BYTES, stream, a);
#endif
}
```
